# Optimizing an MI355X kernel written in HIP

```python
import math
import jax, jax.numpy as jnp
from jax import lax
import numpy as np

D_MODEL = 1024
BATCH = 4
SEQ = 4096
DEPTH = 4

PLE_DIM = 256
D_FF = 2816
SB_HEADS = 8
SB_HEAD_DIM = 64
DF_HEADS = 4
DF_QK_DIM = 64
DF_V_DIM = 2 * DF_QK_DIM
SB_W = SB_HEADS * SB_HEAD_DIM
DF_QK_W = DF_HEADS * 2 * DF_QK_DIM
DF_W = DF_HEADS * DF_V_DIM
IN_SPLITS = (SB_W, SB_W, SB_W, DF_QK_W, DF_QK_W, DF_W, D_MODEL, D_MODEL)
D_IN = SB_W * 3 + DF_QK_W * 2 + DF_W + 2 * D_MODEL
BLOCK_Q = 128
ROPE_THETA = 10000.0
NORM_EPS = 1e-6
SUBLN_EPS = 1e-5

kernel_name = "hybrid_stickbreak_diffattn_macaron_trunk"


def rms_norm(x, g, eps=NORM_EPS):
    xf = x.astype(jnp.float32)
    y = xf * lax.rsqrt(jnp.mean(xf * xf, axis=-1, keepdims=True) + eps)
    return (y * g.astype(jnp.float32)).astype(x.dtype)


def swiglu(x, w_gu, w_down):
    g, u = jnp.split(x @ w_gu, 2, axis=-1)
    return (jax.nn.silu(g) * u) @ w_down


def rope(x, positions):
    half = x.shape[-1] // 2
    inv_freq = ROPE_THETA ** (-jnp.arange(half, dtype=jnp.float32) / half)
    ang = positions.astype(jnp.float32)[..., None] * inv_freq
    cos = jnp.cos(ang)[:, :, None, None, :]
    sin = jnp.sin(ang)[:, :, None, None, :]
    x1 = x[..., :half].astype(jnp.float32)
    x2 = x[..., half:].astype(jnp.float32)
    return jnp.concatenate([x1 * cos - x2 * sin, x2 * cos + x1 * sin], axis=-1).astype(x.dtype)


def to_query_blocks(q):
    b, h, s = q.shape[:3]
    qb = q.reshape((b, h, s // BLOCK_Q, BLOCK_Q) + q.shape[3:])
    return jnp.moveaxis(qb, 2, 0)


def from_query_blocks(o):
    nb, b, h, bq, d = o.shape
    return jnp.moveaxis(o, 0, 2).reshape(b, h, nb * bq, d)


def stick_breaking_attention(q, k, v):
    s_len, d = q.shape[2], q.shape[3]
    scale = 1.0 / math.sqrt(d)
    key_pos = jnp.arange(s_len)

    def one_block(args):
        qi, bi = args
        q_pos = bi * BLOCK_Q + jnp.arange(BLOCK_Q)
        strict = key_pos[None, :] < q_pos[:, None]
        z = jnp.einsum('bhqd,bhkd->bhqk', qi, k).astype(jnp.float32) * scale
        log_one_minus = jnp.where(strict, jax.nn.log_sigmoid(-z), 0.0)
        later = lax.cumsum(log_one_minus, axis=3, reverse=True) - log_one_minus
        w = jnp.where(strict, jnp.exp(jax.nn.log_sigmoid(z) + later), 0.0)
        return jnp.einsum('bhqk,bhkd->bhqd', w.astype(v.dtype), v)

    nb = s_len // BLOCK_Q
    out = lax.map(one_block, (to_query_blocks(q), jnp.arange(nb)))
    return from_query_blocks(out)


def differential_attention(q, k, v, lam):
    s_len, d = q.shape[2], q.shape[4]
    scale = 1.0 / math.sqrt(d)
    key_pos = jnp.arange(s_len)

    def one_block(args):
        qi, bi = args
        q_pos = bi * BLOCK_Q + jnp.arange(BLOCK_Q)
        causal = key_pos[None, :] <= q_pos[:, None]
        z = jnp.einsum('bhqcd,bhkcd->bhcqk', qi, k).astype(jnp.float32) * scale
        z = jnp.where(causal, z, -jnp.inf)
        probs = jax.nn.softmax(z, axis=-1)
        a = probs[:, :, 0] - lam * probs[:, :, 1]
        return jnp.einsum('bhqk,bhkd->bhqd', a.astype(v.dtype), v)

    nb = s_len // BLOCK_Q
    out = lax.map(one_block, (to_query_blocks(q), jnp.arange(nb)))
    return from_query_blocks(out)


def setup_inputs(seed: int = 0) -> dict:
    key = jax.random.key(seed)
    ks = jax.random.split(key, 24)
    f32 = jnp.float32

    def w(k, shape, fan_in):
        return jax.random.normal(k, shape, f32) * (fan_in ** -0.5)

    def gain(k, n):
        return 1.0 + 0.05 * jax.random.normal(k, (DEPTH, n), f32)

    offsets = jax.random.randint(ks[2], (BATCH, 1), 0, SEQ, dtype=jnp.int32)
    positions = (jnp.arange(SEQ, dtype=jnp.int32)[None, :] + offsets).astype(jnp.int32)
    return {
        "x": jax.random.normal(ks[0], (BATCH, SEQ, D_MODEL), f32),
        "p": jax.random.normal(ks[1], (DEPTH, BATCH, SEQ, PLE_DIM), f32),
        "positions": positions,
        "ffn1_pre_g": gain(ks[3], D_MODEL),
        "ffn1_w_gu": w(ks[4], (DEPTH, D_MODEL, 2 * D_FF), D_MODEL),
        "ffn1_w_down": w(ks[5], (DEPTH, D_FF, D_MODEL), D_FF),
        "ffn1_post_g": gain(ks[6], D_MODEL),
        "mix_pre_g": gain(ks[7], D_MODEL),
        "w_in": w(ks[8], (DEPTH, D_MODEL, D_IN), D_MODEL),
        "diff_lambda": 0.1 * jax.random.normal(ks[9], (DEPTH, 4, DF_QK_DIM), f32),
        "diff_subln_g": gain(ks[10], DF_V_DIM),
        "w_branch_sb": w(ks[11], (DEPTH, SB_W, D_MODEL), SB_W),
        "w_branch_diff": w(ks[12], (DEPTH, DF_W, D_MODEL), DF_W),
        "w_out": w(ks[13], (DEPTH, D_MODEL, D_MODEL), D_MODEL),
        "mix_post_g": gain(ks[14], D_MODEL),
        "ffn2_pre_g": gain(ks[15], D_MODEL),
        "ffn2_w_gu": w(ks[16], (DEPTH, D_MODEL, 2 * D_FF), D_MODEL),
        "ffn2_w_down": w(ks[17], (DEPTH, D_FF, D_MODEL), D_FF),
        "ffn2_post_g": gain(ks[18], D_MODEL),
        "ple_pre_g": gain(ks[19], D_MODEL),
        "w_ple_gate": w(ks[20], (DEPTH, D_MODEL, D_MODEL), D_MODEL),
        "w_ple_proj": w(ks[21], (DEPTH, PLE_DIM, D_MODEL), PLE_DIM),
        "ple_post_g": gain(ks[22], D_MODEL),
    }


def reference(x, p, positions,
              ffn1_pre_g, ffn1_w_gu, ffn1_w_down, ffn1_post_g,
              mix_pre_g, w_in, diff_lambda, diff_subln_g, w_branch_sb, w_branch_diff, w_out, mix_post_g,
              ffn2_pre_g, ffn2_w_gu, ffn2_w_down, ffn2_post_g,
              ple_pre_g, w_ple_gate, w_ple_proj, ple_post_g):
    b, s, _ = x.shape
    split_at = [int(o) for o in np.cumsum(IN_SPLITS)[:-1]]
    h = x
    for i in range(DEPTH):
        f = swiglu(rms_norm(h, ffn1_pre_g[i]), ffn1_w_gu[i], ffn1_w_down[i])
        h = h + 0.5 * rms_norm(f, ffn1_post_g[i])

        u = rms_norm(h, mix_pre_g[i])
        sb_q, sb_k, sb_v, df_q, df_k, df_v, g_sb, g_df = jnp.split(u @ w_in[i], split_at, axis=-1)

        heads_sb = lambda t: t.reshape(b, s, SB_HEADS, SB_HEAD_DIM).transpose(0, 2, 1, 3)
        o_sb = stick_breaking_attention(heads_sb(sb_q), heads_sb(sb_k), heads_sb(sb_v))
        y_sb = o_sb.transpose(0, 2, 1, 3).reshape(b, s, SB_W) @ w_branch_sb[i]

        lam_init = 0.8 - 0.6 * math.exp(-0.3 * i)
        lp = diff_lambda[i].astype(jnp.float32)
        lam = jnp.exp(jnp.sum(lp[0] * lp[1])) - jnp.exp(jnp.sum(lp[2] * lp[3])) + lam_init
        dq = rope(df_q.reshape(b, s, DF_HEADS, 2, DF_QK_DIM), positions).transpose(0, 2, 1, 3, 4)
        dk = rope(df_k.reshape(b, s, DF_HEADS, 2, DF_QK_DIM), positions).transpose(0, 2, 1, 3, 4)
        dv = df_v.reshape(b, s, DF_HEADS, DF_V_DIM).transpose(0, 2, 1, 3)
        o_df = differential_attention(dq, dk, dv, lam)
        o_df = rms_norm(o_df, diff_subln_g[i], SUBLN_EPS) * (1.0 - lam_init)
        y_df = o_df.transpose(0, 2, 1, 3).reshape(b, s, DF_W) @ w_branch_diff[i]

        merged = jax.nn.sigmoid(g_sb) * y_sb + jax.nn.sigmoid(g_df) * y_df
        h = h + rms_norm(merged @ w_out[i], mix_post_g[i])

        f = swiglu(rms_norm(h, ffn2_pre_g[i]), ffn2_w_gu[i], ffn2_w_down[i])
        h = h + 0.5 * rms_norm(f, ffn2_post_g[i])

        gate = jax.nn.sigmoid(rms_norm(h, ple_pre_g[i]) @ w_ple_gate[i])
        e = (p[i] @ w_ple_proj[i]) * gate
        h = h + rms_norm(e, ple_post_g[i])
    return h
```

```cpp
#include <hip/hip_runtime.h>
#include <hip/hip_cooperative_groups.h>
#include <cstdio>
#include <cstdint>
#include <cmath>
namespace cg = cooperative_groups;
namespace pg8 {
#define PG8_LAS __attribute__((address_space(3)))
typedef unsigned short bf16_t;
typedef short bf16x8 __attribute__((ext_vector_type(8)));
typedef float f32x4 __attribute__((ext_vector_type(4)));
typedef unsigned u32x4 __attribute__((ext_vector_type(4)));
constexpr int BM = 256, BK = 64, HALF = 128, HTB = HALF * BK * 2  , STAGE_BYTES = 8 * HTB, NXCD = 8, WGM = 8;

__host__ __device__ __forceinline__ int lds_byte(int r, int c) { const int st = (r >> 4) * 2 + (c >> 5), rr = r & 15, cc = c & 31, ob = rr * 64 + cc * 2; return st * 1024 + (ob ^ (((ob >> 9) & 1) << 5)); }
__host__ __device__ __forceinline__ void stage_rc(int b, int& R, int& C) { const int st = b / 1024, sb = b % 1024, swz = sb ^ (((sb >> 9) & 1) << 5); R = (st >> 1) * 16 + swz / 64; C = (st & 1) * 32 + (swz % 64) / 2; }
__host__ __device__ __forceinline__ int perm32(int rho) { const int n = rho >> 4, i = rho & 15; return 8 * (i >> 2) + 4 * n + (i & 3); }

struct Unit { int pm, pn; };
struct Gemm { const bf16_t* A; const bf16_t* Bt; int M, N, K; };

struct StaticOrder {
    int nM, nN, nwg, G, c;
    __host__ __device__ void init(int M, int N, int G_, int c_) { nM = M / BM; nN = N / BM; nwg = nM * nN; G = G_; c = c_; }
    __host__ __device__ bool next(int i, Unit& u) const {
        const long L = (long)i * G + c; if (L >= nwg) return false;
        int wgid = (int)L; { const int q = nwg / NXCD, r = nwg % NXCD, xcd = wgid % NXCD, off = wgid / NXCD; wgid = (xcd < r ? xcd * (q + 1) : r * (q + 1) + (xcd - r) * q) + off; }
        const int nig = WGM * nN, gid = wgid / nig, fm = gid * WGM, gsz = (nM - fm) < WGM ? (nM - fm) : WGM;
        u.pm = fm + ((wgid % nig) % gsz); u.pn = (wgid % nig) / gsz; return true;
    }
    __device__ __forceinline__ void a_ready(const Unit&) const {}
    __device__ __forceinline__ void done(const Unit&) const {}
};

}
namespace pg8 {
template <class Epi, class Sched, bool ALIGN_EPI = false, bool SP2 = false>
__device__ __forceinline__ void gemm_phase(PG8_LAS unsigned char* lds, const Gemm g, const Sched& S, const Epi& E) {
    int tid_ = threadIdx.x; asm volatile("" : "+v"(tid_));
    const int tid = tid_, wid = __builtin_amdgcn_readfirstlane(tid >> 6), lane = tid & 63, wr = wid >> 2, wc = wid & 3, fr = lane & 15, fq = lane >> 4;
    const int K = g.K, nt = K / BK;
    unsigned voffA[2], voffB[2];
#pragma unroll
    for (int i = 0; i < 2; ++i) { int R, C; stage_rc(tid * 16 + i * 8192, R, C); const int Rb = Epi::PERM ? ((R & ~31) + perm32(R & 31)) : R;
        voffA[i] = (unsigned)(R * K + C) * 2u; voffB[i] = (unsigned)(Rb * K + C) * 2u; }
    const size_t kstep = (size_t)(BK * 2);
    const size_t hstep = (size_t)HALF * K * 2;
    const size_t tstep = 2 * hstep;
    const unsigned ldsw = (unsigned)wid * 1024u;
    const int aoff = lds_byte(wr * 64 + fr, fq * 8), boff = lds_byte(wc * 32 + fr, fq * 8);
#define PG8_SA(b, h) (((b) * 2 + (h)) * HTB)
#define PG8_SB(b, h) ((4 + (b) * 2 + (h)) * HTB)
#define PG8_STAGE(bufoff, gbase, voff) do { _Pragma("unroll") for (int _i = 0; _i < 2; ++_i) \
        __builtin_amdgcn_global_load_lds((const unsigned*)((const char*)(gbase) + (voff)[_i]), (PG8_LAS unsigned*)(lds + (bufoff) + ldsw + _i * 8192), 16, 0, 0); } while (0)
#define PG8_LDA(dst, b, h) do { _Pragma("unroll") for (int m = 0; m < 4; ++m) _Pragma("unroll") for (int k = 0; k < 2; ++k) dst[m][k] = *(const PG8_LAS bf16x8*)(lds + PG8_SA(b, h) + aoff + m * 2048 + k * 1024); } while (0)
#define PG8_LDB(dst, b, h) do { _Pragma("unroll") for (int n = 0; n < 2; ++n) _Pragma("unroll") for (int k = 0; k < 2; ++k) dst[n][k] = *(const PG8_LAS bf16x8*)(lds + PG8_SB(b, h) + boff + n * 2048 + k * 1024); } while (0)
#define PG8_MMA(ai, bj, At, Bt) do { __builtin_amdgcn_s_setprio(1); _Pragma("unroll") for (int m = 0; m < 4; ++m) _Pragma("unroll") for (int n = 0; n < 2; ++n) _Pragma("unroll") for (int k = 0; k < 2; ++k) \
        acc[ai][bj][m][n] = __builtin_amdgcn_mfma_f32_16x16x32_bf16(Bt[n][k], At[m][k], acc[ai][bj][m][n], 0, 0, 0); __builtin_amdgcn_s_setprio(0); } while (0)
#define PG8_WAIT_V(n) asm volatile("s_waitcnt vmcnt(" #n ")" ::: "memory")
#define PG8_WAIT_L(n) asm volatile("s_waitcnt lgkmcnt(" #n ")" ::: "memory")
#define PG8_BAR __builtin_amdgcn_s_barrier()
#define PG8_SCHED __builtin_amdgcn_sched_barrier(0)
    Unit cur, nxt; int ui = 0;
    if (!S.next(0, cur)) return;
    f32x4 acc[2][2][4][2];
#pragma unroll
    for (int a = 0; a < 2; ++a)
#pragma unroll
        for (int b = 0; b < 2; ++b)
#pragma unroll
            for (int m = 0; m < 4; ++m)
#pragma unroll
                for (int n = 0; n < 2; ++n) acc[a][b][m][n] = (f32x4){0.f, 0.f, 0.f, 0.f};
    bf16x8 At[4][2], B0[2][2], B1[2][2];
    const char* cA = (const char*)g.A + (size_t)cur.pm * tstep; const char* cB = (const char*)g.Bt + (size_t)cur.pn * tstep;
    S.a_ready(cur);
    if constexpr (SP2) {
        PG8_STAGE(PG8_SB(0, 0), cB, voffB); PG8_STAGE(PG8_SB(0, 1), cB + hstep, voffB); PG8_STAGE(PG8_SA(0, 0), cA, voffA); PG8_STAGE(PG8_SA(0, 1), cA + hstep, voffA);
        if (wr == 1) PG8_BAR;
        PG8_WAIT_V(2); PG8_BAR;
        PG8_STAGE(PG8_SB(1, 0), cB + kstep, voffB); PG8_STAGE(PG8_SA(1, 0), cA + kstep, voffA); PG8_STAGE(PG8_SB(1, 1), cB + hstep + kstep, voffB);
        PG8_WAIT_V(6); PG8_BAR;
    } else {
        PG8_STAGE(PG8_SB(0, 0), cB, voffB); PG8_STAGE(PG8_SA(0, 0), cA, voffA); PG8_STAGE(PG8_SB(0, 1), cB + hstep, voffB); PG8_STAGE(PG8_SA(0, 1), cA + hstep, voffA);
        if (wr == 1) PG8_BAR;
        PG8_WAIT_V(4); PG8_BAR;
        PG8_STAGE(PG8_SB(1, 0), cB + kstep, voffB); PG8_STAGE(PG8_SA(1, 0), cA + kstep, voffA); PG8_STAGE(PG8_SB(1, 1), cB + hstep + kstep, voffB);
        PG8_WAIT_V(6); PG8_BAR;
    }
    for (;;) {
        const bool has_next = S.next(ui + 1, nxt);
        const char* nA = has_next ? (const char*)g.A + (size_t)nxt.pm * tstep : cA; const char* nB = has_next ? (const char*)g.Bt + (size_t)nxt.pn * tstep : cB;
#pragma unroll 1
        for (int t = 0; t < nt; t += 2) {
            const bool last = (t == nt - 2);
            const char* a1 = cA + (size_t)(t + 1) * kstep;
            const char* a2 = last ? nA : cA + (size_t)(t + 2) * kstep; const char* b2 = last ? nB : cB + (size_t)(t + 2) * kstep;
            const char* a3 = a2 + kstep; const char* b3 = b2 + kstep;
            if (last && has_next) S.a_ready(nxt);
            if constexpr (SP2) {
            PG8_LDB(B0, 0, 0); PG8_LDB(B1, 0, 1); PG8_SCHED; PG8_LDA(At, 0, 0); PG8_STAGE(PG8_SA(1, 1), a1 + hstep, voffA);
            PG8_WAIT_V(8); PG8_WAIT_L(0); PG8_BAR; PG8_MMA(0, 0, At, B0); PG8_MMA(0, 1, At, B1); PG8_BAR; PG8_SCHED;
            PG8_LDA(At, 0, 1); PG8_STAGE(PG8_SB(0, 0), b2, voffB); PG8_STAGE(PG8_SB(0, 1), b2 + hstep, voffB); PG8_STAGE(PG8_SA(0, 0), a2, voffA);
            PG8_WAIT_V(8); PG8_WAIT_L(0); PG8_BAR; PG8_MMA(1, 0, At, B0); PG8_MMA(1, 1, At, B1); PG8_BAR; PG8_SCHED;
            PG8_LDB(B0, 1, 0); PG8_LDB(B1, 1, 1); PG8_SCHED; PG8_LDA(At, 1, 0); PG8_STAGE(PG8_SA(0, 1), a2 + hstep, voffA);
            PG8_WAIT_V(8); PG8_WAIT_L(0); PG8_BAR; PG8_MMA(0, 0, At, B0); PG8_MMA(0, 1, At, B1); PG8_BAR; PG8_SCHED;
            PG8_LDA(At, 1, 1); PG8_STAGE(PG8_SB(1, 0), b3, voffB); PG8_STAGE(PG8_SB(1, 1), b3 + hstep, voffB); PG8_STAGE(PG8_SA(1, 0), a3, voffA);
            PG8_WAIT_V(8); PG8_WAIT_L(0); PG8_BAR; PG8_MMA(1, 0, At, B0); PG8_MMA(1, 1, At, B1); PG8_BAR; PG8_SCHED;
            } else {
            PG8_LDB(B0, 0, 0); PG8_SCHED; PG8_LDA(At, 0, 0); PG8_STAGE(PG8_SA(1, 1), a1 + hstep, voffA);
            PG8_WAIT_L(8); PG8_BAR; PG8_WAIT_L(0); PG8_MMA(0, 0, At, B0); PG8_BAR; PG8_SCHED;
            PG8_LDB(B1, 0, 1); PG8_STAGE(PG8_SB(0, 0), b2, voffB);
            PG8_BAR; PG8_WAIT_L(0); PG8_MMA(0, 1, At, B1); PG8_BAR;
            PG8_LDA(At, 0, 1); PG8_STAGE(PG8_SA(0, 0), a2, voffA);
            PG8_BAR; PG8_WAIT_L(0); PG8_MMA(1, 0, At, B0); PG8_BAR; PG8_SCHED;
            PG8_STAGE(PG8_SB(0, 1), b2 + hstep, voffB);
            PG8_WAIT_V(6); PG8_BAR; PG8_MMA(1, 1, At, B1); PG8_BAR;
            PG8_LDB(B0, 1, 0); PG8_SCHED; PG8_LDA(At, 1, 0); PG8_STAGE(PG8_SA(0, 1), a2 + hstep, voffA);
            PG8_WAIT_L(8); PG8_BAR; PG8_WAIT_L(0); PG8_MMA(0, 0, At, B0); PG8_BAR; PG8_SCHED;
            PG8_LDB(B1, 1, 1); PG8_STAGE(PG8_SB(1, 0), b3, voffB);
            PG8_BAR; PG8_WAIT_L(0); PG8_MMA(0, 1, At, B1); PG8_BAR;
            PG8_LDA(At, 1, 1); PG8_STAGE(PG8_SA(1, 0), a3, voffA);
            PG8_BAR; PG8_WAIT_L(0); PG8_MMA(1, 0, At, B0); PG8_BAR; PG8_SCHED;
            PG8_STAGE(PG8_SB(1, 1), b3 + hstep, voffB);
            PG8_WAIT_V(6); PG8_BAR; PG8_MMA(1, 1, At, B1); PG8_BAR;
            }
        }
        if constexpr (ALIGN_EPI) { if (wr == 0) PG8_BAR; }
        if constexpr (!Epi::AFTER_DRAIN) { E(acc, cur, wr, wc, fr, fq); S.done(cur); }
        if (!has_next) break;
#pragma unroll
        for (int a = 0; a < 2; ++a)
#pragma unroll
            for (int b = 0; b < 2; ++b)
#pragma unroll
                for (int m = 0; m < 4; ++m)
#pragma unroll
                    for (int n = 0; n < 2; ++n) acc[a][b][m][n] = (f32x4){0.f, 0.f, 0.f, 0.f};
        cur = nxt; cA = nA; cB = nB; ++ui;
        if constexpr (ALIGN_EPI) { if (wr == 1) PG8_BAR; }
    }
    PG8_WAIT_V(0);
    if constexpr (!ALIGN_EPI) { if (wr == 0) PG8_BAR; }
    PG8_BAR;
    if constexpr (Epi::AFTER_DRAIN) { E.fused(acc, cur, wr, wc, fr, fq, lds, wid, lane); S.done(cur); }
#undef PG8_SA
#undef PG8_SB
#undef PG8_STAGE
#undef PG8_LDA
#undef PG8_LDB
#undef PG8_MMA
#undef PG8_WAIT_V
#undef PG8_WAIT_L
#undef PG8_BAR
#undef PG8_SCHED
}
}
#define LAS __attribute__((address_space(3)))
typedef unsigned short bf16_t;
typedef short bf16x8 __attribute__((ext_vector_type(8)));
typedef short s16x4 __attribute__((ext_vector_type(4)));
typedef float f32x4 __attribute__((ext_vector_type(4)));
typedef float f32x16 __attribute__((ext_vector_type(16)));
typedef unsigned u32x4 __attribute__((ext_vector_type(4)));
typedef unsigned u32x2 __attribute__((ext_vector_type(2)));

constexpr int NB = 4, SEQ = 4096, DM = 1024, DFF = 2816, DIN = 5120, DEPTH = 4, PLE = 256;
constexpr int M = NB * SEQ;
constexpr size_t MiB = 1u << 20;
constexpr size_t SZ_WGU = (size_t)2 * DFF * DM * 2, SZ_WD = (size_t)DM * DFF * 2, SZ_WIN = (size_t)DIN * DM * 2, SZ_WB = (size_t)DM * 512 * 2, SZ_WO = (size_t)DM * DM * 2, SZ_WPP = (size_t)DM * PLE * 2;
constexpr size_t O_WGU1 = 0, O_WD1 = O_WGU1 + SZ_WGU, O_WIN = O_WD1 + SZ_WD, O_WBS = O_WIN + SZ_WIN, O_WBD = O_WBS + SZ_WB, O_WOUT = O_WBD + SZ_WB, O_WGU2 = O_WOUT + SZ_WO,
                 O_WD2 = O_WGU2 + SZ_WGU, O_WPG = O_WD2 + SZ_WD, O_WPP = O_WPG + SZ_WO, LAYER_W = O_WPP + SZ_WPP;
constexpr size_t WS_W = 0, WS_U = 200 * MiB, WS_F = 232 * MiB, WS_P = 264 * MiB, WS_ROPE = 296 * MiB, WS_R = 300 * MiB, WS_END = 492 * MiB;
static_assert(LAYER_W * DEPTH <= WS_U, "weights fit");
constexpr size_t R_SBQ = 0, R_SBK = 16 * MiB, R_SBV = 32 * MiB, R_DFQ = 48 * MiB, R_DFK = 64 * MiB, R_DFV = 80 * MiB, R_GSB = 96 * MiB, R_GDF = 128 * MiB, R_OSB = 160 * MiB, R_ODF = 176 * MiB;
constexpr size_t R_TMP = 0, R_MRG = 64 * MiB, R_ACT = 0;
constexpr int LDS_BYTES = 147456;
#ifndef PH
#define PH 0xffff
#endif

struct Args {
    const void* in[23];
    float* out;
    unsigned char* ws;
    float invf[32];
    float lam_init[4];
};
static_assert(sizeof(Args) % 8 == 0, "no tail padding");

typedef float f32x2_t __attribute__((ext_vector_type(2))); typedef __bf16 bf16x2_t __attribute__((ext_vector_type(2)));
__device__ __forceinline__ unsigned cvtpk(float lo, float hi) { f32x2_t v = {lo, hi}; bf16x2_t b = __builtin_convertvector(v, bf16x2_t); return __builtin_bit_cast(unsigned, b); }
__device__ __forceinline__ float bflo(unsigned w) { return __uint_as_float(w << 16); }
__device__ __forceinline__ float bfhi(unsigned w) { return __uint_as_float(w & 0xffff0000u); }
__device__ __forceinline__ float wave_sum(float v) {
#pragma unroll
    for (int o = 1; o < 64; o <<= 1) v += __shfl_xor(v, o);
    return v;
}
__device__ __forceinline__ float sigmoidf_(float x) { return __builtin_amdgcn_rcpf(1.0f + __expf(-x)); }

namespace pg8 {
typedef f32x4 (acc_t)[2][2][4][2];
__device__ __forceinline__ u32x4 pack8(const f32x4 v0, const f32x4 v1) { u32x4 w; w.x = cvtpk(v0[0], v0[1]); w.y = cvtpk(v0[2], v0[3]); w.z = cvtpk(v1[0], v1[1]); w.w = cvtpk(v1[2], v1[3]); return w; }
__device__ __forceinline__ void unpack8(const u32x4 w, f32x4& v0, f32x4& v1) { v0 = (f32x4){bflo(w.x), bfhi(w.x), bflo(w.y), bfhi(w.y)}; v1 = (f32x4){bflo(w.z), bfhi(w.z), bflo(w.w), bfhi(w.w)}; }

struct EpiPlain {
    static constexpr bool PERM = true, AFTER_DRAIN = false;
    bf16_t* O; int ldc;
    __device__ __forceinline__ void operator()(const f32x4 (&acc)[2][2][4][2], const Unit& u, int wr, int wc, int fr, int fq) const {
        const int row0 = u.pm * BM + wr * 64 + fr, col0 = u.pn * BM + wc * 32 + 8 * fq;
#pragma unroll
        for (int ai = 0; ai < 2; ++ai)
#pragma unroll
            for (int m = 0; m < 4; ++m) { bf16_t* rowp = O + (size_t)(row0 + ai * HALF + m * 16) * ldc + col0;
#pragma unroll
                for (int bj = 0; bj < 2; ++bj) *(u32x4*)(rowp + bj * HALF) = pack8(acc[ai][bj][m][0], acc[ai][bj][m][1]); }
    }
};
struct EpiSwiglu {
    static constexpr bool PERM = true, AFTER_DRAIN = false;
    bf16_t* O;
    __device__ __forceinline__ void operator()(const f32x4 (&acc)[2][2][4][2], const Unit& u, int wr, int wc, int fr, int fq) const {
        const int row0 = u.pm * BM + wr * 64 + fr, col0 = u.pn * HALF + wc * 32 + 8 * fq;
#pragma unroll
        for (int ai = 0; ai < 2; ++ai)
#pragma unroll
            for (int m = 0; m < 4; ++m) { bf16_t* rowp = O + (size_t)(row0 + ai * HALF + m * 16) * DFF + col0;
                f32x4 o[2];
#pragma unroll
                for (int n = 0; n < 2; ++n) { const f32x4 g = acc[ai][0][m][n], uu = acc[ai][1][m][n];
#pragma unroll
                    for (int e = 0; e < 4; ++e) o[n][e] = g[e] * sigmoidf_(g[e]) * uu[e]; }
                *(u32x4*)rowp = pack8(o[0], o[1]); }
    }
};
struct EpiWin {
    static constexpr bool PERM = true, AFTER_DRAIN = false;
    bf16_t* R; const float* rope;
    __device__ __forceinline__ void operator()(const f32x4 (&acc)[2][2][4][2], const Unit& u, int wr, int wc, int fr, int fq) const {
        const int pn = u.pn, row0 = u.pm * BM + wr * 64 + fr, cl = wc * 32 + 8 * fq;
        if (pn < 12) {
            const int sec = pn >> 1;
            bf16_t* base = R + (size_t)sec * ((size_t)M * 512) + (pn & 1) * 256 + cl;
            const float sc = (sec == 0) ? 0.125f : ((sec == 3) ? 0.125f * 1.4426950408889634f : 1.0f);
            const bool rp = (sec == 3) || (sec == 4);
#pragma unroll
            for (int ai = 0; ai < 2; ++ai)
#pragma unroll
                for (int m = 0; m < 4; ++m) { const int row = row0 + ai * HALF + m * 16;
                    f32x4 cs0 = {1.f, 0.f, 1.f, 0.f}, cs1 = {1.f, 0.f, 1.f, 0.f};
                    if (rp) { const float* rt = rope + (size_t)row * 64 + (16 * (wc & 1) + 4 * fq) * 2; cs0 = *(const f32x4*)rt; cs1 = *(const f32x4*)(rt + 4); }
                    const f32x4 cc = {cs0[0], cs0[2], cs1[0], cs1[2]}, ss = {cs0[1], cs0[3], cs1[1], cs1[3]};
#pragma unroll
                    for (int bj = 0; bj < 2; ++bj) { const f32x4 x1 = acc[ai][bj][m][0] * sc, x2 = acc[ai][bj][m][1] * sc;
                        const f32x4 y1 = x1 * cc - x2 * ss, y2 = x2 * cc + x1 * ss;
                        *(u32x4*)(base + (size_t)row * 512 + bj * HALF) = pack8(y1, y2); } }
        } else {
            const int t = pn - 12;
            bf16_t* base = R + (size_t)6 * ((size_t)M * 512) + (size_t)(t >> 2) * ((size_t)M * 1024) + (t & 3) * 256 + cl;
#pragma unroll
            for (int ai = 0; ai < 2; ++ai)
#pragma unroll
                for (int m = 0; m < 4; ++m) { const int row = row0 + ai * HALF + m * 16;
#pragma unroll
                    for (int bj = 0; bj < 2; ++bj) { f32x4 v0 = acc[ai][bj][m][0], v1 = acc[ai][bj][m][1];
#pragma unroll
                        for (int e = 0; e < 4; ++e) { v0[e] = sigmoidf_(v0[e]); v1[e] = sigmoidf_(v1[e]); }
                        *(u32x4*)(base + (size_t)row * 1024 + bj * HALF) = pack8(v0, v1); } }
        }
    }
};
template <int MODE> struct EpiTwo {
    static constexpr bool PERM = true, AFTER_DRAIN = false;
    float* tmp; const bf16_t* G; bf16_t* O;
    __device__ __forceinline__ void operator()(const f32x4 (&acc)[2][2][4][2], const Unit& u, int wr, int wc, int fr, int fq) const {
        const int row0 = u.pm * BM + wr * 64 + fr, col0 = u.pn * BM + wc * 32 + 8 * fq;
#pragma unroll
        for (int ai = 0; ai < 2; ++ai)
#pragma unroll
            for (int m = 0; m < 4; ++m) { const size_t off = (size_t)(row0 + ai * HALF + m * 16) * 1024 + col0;
#pragma unroll
                for (int bj = 0; bj < 2; ++bj) { f32x4 v0 = acc[ai][bj][m][0], v1 = acc[ai][bj][m][1]; const size_t o2 = off + bj * HALF;
                    if (MODE == 0 || MODE == 1) { f32x4 g0, g1; unpack8(*(const u32x4*)(G + o2), g0, g1); v0 = v0 * g0; v1 = v1 * g1; }
                    if (MODE == 2) {
#pragma unroll
                        for (int e = 0; e < 4; ++e) { v0[e] = sigmoidf_(v0[e]); v1[e] = sigmoidf_(v1[e]); } }
                    if (MODE == 0 || MODE == 2) { *(f32x4*)(tmp + o2) = v0; *(f32x4*)(tmp + o2 + 4) = v1; }
                    else { const f32x4 t0 = *(const f32x4*)(tmp + o2), t1 = *(const f32x4*)(tmp + o2 + 4);
                        if (MODE == 1) { v0 = v0 + t0; v1 = v1 + t1; } else { v0 = v0 * t0; v1 = v1 * t1; }
                        *(u32x4*)(O + o2) = pack8(v0, v1); } } }
    }
};
}

namespace att {
#define MFMA32(a, b, c) __builtin_amdgcn_mfma_f32_32x32x16_bf16((a), (b), (c), 0, 0, 0)
typedef short v4i16_t __attribute__((ext_vector_type(4)));
__device__ __forceinline__ int crow(int r, int hi) { return (r & 3) + 8 * (r >> 2) + 4 * hi; }
__device__ __forceinline__ s16x4 vtr(LAS const unsigned char* p) { return __builtin_bit_cast(s16x4, __builtin_amdgcn_ds_read_tr16_b64_v4i16((LAS v4i16_t*)p)); }
__device__ __forceinline__ bf16x8 cat8(s16x4 a, s16x4 b) { return (bf16x8){a[0], a[1], a[2], a[3], b[0], b[1], b[2], b[3]}; }
__device__ __forceinline__ bf16x8 packp(const f32x16& p, int s) { u32x4 w; w.x = cvtpk(p[8 * s], p[8 * s + 1]); w.y = cvtpk(p[8 * s + 2], p[8 * s + 3]); w.z = cvtpk(p[8 * s + 4], p[8 * s + 5]); w.w = cvtpk(p[8 * s + 6], p[8 * s + 7]); return __builtin_bit_cast(bf16x8, w); }

__device__ __forceinline__ void df_unit(LAS unsigned char* lds, int b, int h, int qb, const bf16_t* __restrict__ Q, const bf16_t* __restrict__ K, const bf16_t* __restrict__ V, bf16_t* __restrict__ O,
                                        float lam, float oscale, const float* __restrict__ subg) {
    int tid_ = threadIdx.x; asm volatile("" : "+v"(tid_));
    const int tid = tid_, lane = tid & 63, wid = __builtin_amdgcn_readfirstlane(tid >> 6), r32 = lane & 31, hi = lane >> 5;
    const int c = wid >> 2, wq = wid & 3;
    const size_t rowbase = (size_t)b * SEQ;
    const int q0 = qb * 128, qw0 = q0 + 32 * wq, NT = (q0 + 128) / 64;
    const bf16_t* kg = K + (rowbase + lane) * 512 + h * 128 + wid * 8;
    const bf16_t* vg = V + (rowbase + 16 * (wid & 3) + (lane >> 2)) * 512 + h * 128 + (wid >> 2) * 32 + (lane & 3) * 8;
    u32x4 rk1, rk2, rv0, rv1;
#define DF_LOAD(t) do { const size_t off_ = (size_t)(t) * 64 * 512; rk1 = *(const u32x4*)(kg + off_); rk2 = *(const u32x4*)(kg + off_ + 64); rv0 = *(const u32x4*)(vg + off_); rv1 = *(const u32x4*)(vg + off_ + 64); } while (0)
#define DF_STORE(s) do { LAS unsigned char* sb_ = lds + (s) * 32768 + wid * 1024 + lane * 16; *(LAS u32x4*)(sb_) = rk1; *(LAS u32x4*)(sb_ + 8192) = rk2; *(LAS u32x4*)(sb_ + 16384) = rv0; *(LAS u32x4*)(sb_ + 24576) = rv1; } while (0)
    bf16x8 qr[4];
    { const bf16_t* qp = Q + (rowbase + qw0 + r32) * 512 + h * 128 + c * 64 + hi * 8;
#pragma unroll
      for (int d0 = 0; d0 < 4; ++d0) qr[d0] = *(const bf16x8*)(qp + d0 * 16); }
    float m_run = -1e30f, l_run = 0.f;
    f32x16 o[4];
#pragma unroll
    for (int d = 0; d < 4; ++d) o[d] = (f32x16){};
    DF_LOAD(0); DF_STORE(0); __syncthreads();
    for (int kt = 0; kt < NT; ++kt) {
        const int s = kt & 1;
        if (kt + 1 < NT) DF_LOAD(kt + 1);
        if (64 * kt <= qw0 + 31) {
            LAS const unsigned char* kb = lds + s * 32768 + c * 8192 + hi * 1024 + r32 * 16;
            f32x16 p0 = (f32x16){}, p1 = (f32x16){};
#pragma unroll
            for (int d0 = 0; d0 < 4; ++d0) { const bf16x8 a0 = *(LAS const bf16x8*)(kb + d0 * 2048), a1 = *(LAS const bf16x8*)(kb + d0 * 2048 + 512);
                p0 = MFMA32(a0, qr[d0], p0); p1 = MFMA32(a1, qr[d0], p1); }
            if (64 * kt + 63 > qw0) { const int q = qw0 + r32, kb0 = 64 * kt + 4 * hi;
#pragma unroll
                for (int r = 0; r < 16; ++r) { const int key = kb0 + (r & 3) + 8 * (r >> 2); if (key > q) p0[r] = -INFINITY; if (key + 32 > q) p1[r] = -INFINITY; } }
            float mx = fmaxf(p0[0], p1[0]);
#pragma unroll
            for (int r = 1; r < 16; ++r) mx = fmaxf(mx, fmaxf(p0[r], p1[r]));
            mx = fmaxf(mx, __shfl_xor(mx, 32));
            const float mn = fmaxf(m_run, mx), sc = __builtin_amdgcn_exp2f(m_run - mn);
            m_run = mn;
            float rs = 0.f;
#pragma unroll
            for (int r = 0; r < 16; ++r) { p0[r] = __builtin_amdgcn_exp2f(p0[r] - mn); p1[r] = __builtin_amdgcn_exp2f(p1[r] - mn); rs += p0[r] + p1[r]; }
            rs += __shfl_xor(rs, 32);
            l_run = l_run * sc + rs;
#pragma unroll
            for (int r = 0; r < 16; ++r) { const float f = __shfl(sc, crow(r, hi));
#pragma unroll
                for (int d = 0; d < 4; ++d) o[d][r] *= f; }
            bf16x8 pa[4]; pa[0] = packp(p0, 0); pa[1] = packp(p0, 1); pa[2] = packp(p1, 0); pa[3] = packp(p1, 1);
            LAS const unsigned char* vb = lds + s * 32768 + 16384 + ((lane >> 4) & 1) * 32 + (lane & 3) * 8 + (4 * hi + ((lane & 15) >> 2)) * 64;
#pragma unroll
            for (int d = 0; d < 4; ++d)
#pragma unroll
                for (int ks = 0; ks < 4; ++ks) { const s16x4 lo = vtr(vb + (d * 4 + ks) * 1024), hh = vtr(vb + (d * 4 + ks) * 1024 + 512); o[d] = MFMA32(pa[ks], cat8(lo, hh), o[d]); }
        }
        if (kt + 1 < NT) DF_STORE(s ^ 1);
        __syncthreads();
    }
#undef DF_LOAD
#undef DF_STORE
    LAS float* ob = (LAS float*)lds;
    const float linv_own = 1.0f / l_run;
    const float wgt = (c == 1) ? -lam : 1.0f;
    if (c == 1) {
#pragma unroll
        for (int r = 0; r < 16; ++r) { const float f = __shfl(linv_own, crow(r, hi)) * wgt; const int row = 32 * wq + crow(r, hi);
#pragma unroll
            for (int d = 0; d < 4; ++d) ob[row * 132 + 32 * d + r32] = o[d][r] * f; }
    }
    __syncthreads();
    if (c == 0) {
#pragma unroll
        for (int r = 0; r < 16; ++r) { const float f = __shfl(linv_own, crow(r, hi)); const int row = 32 * wq + crow(r, hi);
#pragma unroll
            for (int d = 0; d < 4; ++d) ob[row * 132 + 32 * d + r32] += o[d][r] * f; }
    }
    __syncthreads();
    { const int row = tid >> 2, part = tid & 3; const LAS float* rp = ob + row * 132 + part * 32;
      f32x4 v[8]; float ss = 0.f;
#pragma unroll
      for (int j = 0; j < 8; ++j) { v[j] = *(const LAS f32x4*)(rp + 4 * j); ss += (v[j][0] * v[j][0] + v[j][1] * v[j][1]) + (v[j][2] * v[j][2] + v[j][3] * v[j][3]); }
      ss += __shfl_xor(ss, 1); ss += __shfl_xor(ss, 2);
      const float rn = oscale / sqrtf(ss * (1.0f / 128.0f) + 1e-5f);
      bf16_t* op = O + (rowbase + q0 + row) * 512 + h * 128 + part * 32;
#pragma unroll
      for (int j = 0; j < 4; ++j) { const f32x4 g0 = *(const f32x4*)(subg + part * 32 + 8 * j), g1 = *(const f32x4*)(subg + part * 32 + 8 * j + 4);
          const f32x4 a = v[2 * j] * g0 * rn, bb = v[2 * j + 1] * g1 * rn;
          u32x4 w; w.x = cvtpk(a[0], a[1]); w.y = cvtpk(a[2], a[3]); w.z = cvtpk(bb[0], bb[1]); w.w = cvtpk(bb[2], bb[3]);
          *(u32x4*)(op + 8 * j) = w; } }
    __syncthreads();
}

__device__ __forceinline__ void sb_unit(LAS unsigned char* lds, int b, int h, int qb, const bf16_t* __restrict__ Q, const bf16_t* __restrict__ K, const bf16_t* __restrict__ V, bf16_t* __restrict__ O) {
    int tid_ = threadIdx.x; asm volatile("" : "+v"(tid_));
    const int tid = tid_, lane = tid & 63, wid = __builtin_amdgcn_readfirstlane(tid >> 6), r32 = lane & 31, hi = lane >> 5;
    const size_t rowbase = (size_t)b * SEQ;
    const int q0 = qb * 256, qw0 = q0 + 32 * wid, kt_hi = (q0 + 256) / 64 - 1;
    const bf16_t* kg = K + (rowbase + lane) * 512 + h * 64 + wid * 8;
    const bf16_t* vg = V + (rowbase + 16 * (wid & 3) + (lane >> 2)) * 512 + h * 64 + (wid >> 2) * 32 + (lane & 3) * 8;
    LAS unsigned* flags = (LAS unsigned*)(lds + 32768);
    LAS unsigned char* ost = lds + 36864 + wid * 4608;
    u32x4 rk, rv;
#define SB_LOAD(t) do { const size_t off_ = (size_t)(t) * 64 * 512; rk = *(const u32x4*)(kg + off_); rv = *(const u32x4*)(vg + off_); } while (0)
#define SB_STORE(s) do { LAS unsigned char* sb_ = lds + (s) * 16384 + wid * 1024 + lane * 16; *(LAS u32x4*)(sb_) = rk; *(LAS u32x4*)(sb_ + 8192) = rv; } while (0)
    bf16x8 qr[4];
    { const bf16_t* qp = Q + (rowbase + qw0 + r32) * 512 + h * 64 + hi * 8;
#pragma unroll
      for (int d0 = 0; d0 < 4; ++d0) qr[d0] = *(const bf16x8*)(qp + d0 * 16); }
    float carry = 0.f; bool done = false;
    f32x16 o[2]; o[0] = (f32x16){}; o[1] = (f32x16){};
    SB_LOAD(kt_hi); SB_STORE(0); __syncthreads();
    int it = 0;
    for (int kt = kt_hi; kt >= 0; --kt, ++it) {
        const int s = it & 1;
        if (kt > 0) SB_LOAD(kt - 1);
        if (!done && 64 * kt < qw0 + 31) {
            LAS const unsigned char* kb = lds + s * 16384 + hi * 1024 + r32 * 16;
            f32x16 p0 = (f32x16){}, p1 = (f32x16){};
#pragma unroll
            for (int d0 = 0; d0 < 4; ++d0) { const bf16x8 a0 = *(LAS const bf16x8*)(kb + d0 * 2048), a1 = *(LAS const bf16x8*)(kb + d0 * 2048 + 512);
                p0 = MFMA32(a0, qr[d0], p0); p1 = MFMA32(a1, qr[d0], p1); }
            const int q = qw0 + r32, kb0 = 64 * kt + 4 * hi;
            f32x16 L0, L1;
#pragma unroll
            for (int r = 0; r < 16; ++r) { const int key = kb0 + (r & 3) + 8 * (r >> 2);
                { const float z = p0[r], sp = fmaxf(z, 0.f) + __logf(1.0f + __expf(-fabsf(z))); const bool v = key < q; L0[r] = v ? -sp : 0.f; p0[r] = v ? (z - sp) : -1e30f; }
                { const float z = p1[r], sp = fmaxf(z, 0.f) + __logf(1.0f + __expf(-fabsf(z))); const bool v = (key + 32) < q; L1[r] = v ? -sp : 0.f; p1[r] = v ? (z - sp) : -1e30f; } }
            float own[8], par[8], S[8];
#pragma unroll
            for (int j = 0; j < 4; ++j) { own[j] = (L0[4 * j] + L0[4 * j + 1]) + (L0[4 * j + 2] + L0[4 * j + 3]); own[4 + j] = (L1[4 * j] + L1[4 * j + 1]) + (L1[4 * j + 2] + L1[4 * j + 3]); }
#pragma unroll
            for (int j = 0; j < 8; ++j) par[j] = __shfl_xor(own[j], 32);
            S[7] = 0.f;
#pragma unroll
            for (int j = 6; j >= 0; --j) S[j] = S[j + 1] + (own[j + 1] + par[j + 1]);
            const float total = S[0] + (own[0] + par[0]);
#pragma unroll
            for (int j = 0; j < 8; ++j) { const float lg = carry + S[j] + (hi == 0 ? par[j] : 0.f);
                if (j < 4) { const int rb = 4 * j; const float l3 = lg, l2 = l3 + L0[rb + 3], l1 = l2 + L0[rb + 2], l0 = l1 + L0[rb + 1];
                    p0[rb] = __expf(p0[rb] + l0); p0[rb + 1] = __expf(p0[rb + 1] + l1); p0[rb + 2] = __expf(p0[rb + 2] + l2); p0[rb + 3] = __expf(p0[rb + 3] + l3); }
                else { const int rb = 4 * (j - 4); const float l3 = lg, l2 = l3 + L1[rb + 3], l1 = l2 + L1[rb + 2], l0 = l1 + L1[rb + 1];
                    p1[rb] = __expf(p1[rb] + l0); p1[rb + 1] = __expf(p1[rb + 1] + l1); p1[rb + 2] = __expf(p1[rb + 2] + l2); p1[rb + 3] = __expf(p1[rb + 3] + l3); } }
            carry += total;
            bf16x8 pa[4]; pa[0] = packp(p0, 0); pa[1] = packp(p0, 1); pa[2] = packp(p1, 0); pa[3] = packp(p1, 1);
            LAS const unsigned char* vb = lds + s * 16384 + 8192 + ((lane >> 4) & 1) * 32 + (lane & 3) * 8 + (4 * hi + ((lane & 15) >> 2)) * 64;
#pragma unroll
            for (int d = 0; d < 2; ++d)
#pragma unroll
                for (int ks = 0; ks < 4; ++ks) { const s16x4 lo = vtr(vb + (d * 4 + ks) * 1024), hh = vtr(vb + (d * 4 + ks) * 1024 + 512); o[d] = MFMA32(pa[ks], cat8(lo, hh), o[d]); }
            done = __all(carry < -104.0f) != 0;
        }
        if (lane == 0) flags[s * 8 + wid] = done ? 1u : 0u;
        if (kt > 0) SB_STORE(s ^ 1);
        __syncthreads();
        unsigned all = 1u;
#pragma unroll
        for (int w = 0; w < 8; ++w) all &= flags[s * 8 + w];
        if (all) break;
    }
#undef SB_LOAD
#undef SB_STORE
#pragma unroll
    for (int d = 0; d < 2; ++d)
#pragma unroll
        for (int r = 0; r < 16; r += 2) { const unsigned w = cvtpk(o[d][r], o[d][r + 1]);
            *(LAS unsigned short*)(ost + crow(r, hi) * 144 + (32 * d + r32) * 2) = (unsigned short)(w & 0xffffu);
            *(LAS unsigned short*)(ost + crow(r + 1, hi) * 144 + (32 * d + r32) * 2) = (unsigned short)(w >> 16); }
    asm volatile("s_waitcnt lgkmcnt(0)" ::: "memory");
#pragma unroll
    for (int j = 0; j < 4; ++j) { const int idx = lane + 64 * j, row = idx >> 3, ch = idx & 7;
        const u32x4 w = *(LAS const u32x4*)(ost + row * 144 + ch * 16);
        *(u32x4*)(O + (rowbase + qw0 + row) * 512 + h * 64 + ch * 8) = w; }
    __syncthreads();
}
}

__device__ __forceinline__ int dest_row(int mode, int c) {
    if (mode == 1) { return (c < DFF) ? (256 * (c >> 7) + (c & 127)) : (256 * ((c - DFF) >> 7) + 128 + ((c - DFF) & 127)); }
    if (mode == 2) { if (c >= 1536 && c < 2560) { const int j = c & 63, half = j >> 5, q = (j & 31) >> 2, e = j & 3; return (c & ~63) + 8 * q + 4 * half + e; } return c; }
    return c;
}
__device__ __forceinline__ void transpose_item(const float* __restrict__ W, int K, int N, bf16_t* __restrict__ WT, int mode, LAS float* scr, int item, int lane) {
    const int nblk = N / 32, kb = item / nblk, nb = item % nblk, k0 = 64 * kb, n0 = 32 * nb;
#pragma unroll 8
    for (int i = 0; i < 32; ++i) { const int kk = 2 * i + (lane >> 5); scr[kk * 33 + (lane & 31)] = W[(size_t)(k0 + kk) * N + n0 + (lane & 31)]; }
    asm volatile("s_waitcnt lgkmcnt(0)" ::: "memory");
    const int c = lane & 7;
#pragma unroll
    for (int j = 0; j < 4; ++j) { const int n = (lane >> 3) + 8 * j; const LAS float* s = scr + (8 * c) * 33 + n;
        u32x4 o; o.x = cvtpk(s[0 * 33], s[1 * 33]); o.y = cvtpk(s[2 * 33], s[3 * 33]); o.z = cvtpk(s[4 * 33], s[5 * 33]); o.w = cvtpk(s[6 * 33], s[7 * 33]);
        *(u32x4*)(WT + (size_t)dest_row(mode, n0 + n) * K + k0 + 8 * c) = o; }
    asm volatile("s_waitcnt lgkmcnt(0)" ::: "memory");
}

template <bool HAS_F, bool WRITE_H, bool WRITE_U>
__device__ __forceinline__ void row_pass(const float* __restrict__ hin, float* __restrict__ hout, const bf16_t* __restrict__ F, float coef, const float* __restrict__ gpost, const float* __restrict__ gpre,
                                         bf16_t* __restrict__ U, int gw, int NGW, int lane_in) {
    int lane = lane_in; asm volatile("" : "+v"(lane));
    f32x4 gp[4], gq[4];
#pragma unroll
    for (int j = 0; j < 4; ++j) { gp[j] = HAS_F ? *(const f32x4*)(gpost + 256 * j + 4 * lane) : (f32x4){0.f, 0.f, 0.f, 0.f}; gq[j] = WRITE_U ? *(const f32x4*)(gpre + 256 * j + 4 * lane) : (f32x4){0.f, 0.f, 0.f, 0.f}; }
    for (int m = gw; m < M; m += NGW) {
        f32x4 hv[4];
#pragma unroll
        for (int j = 0; j < 4; ++j) hv[j] = *(const f32x4*)(hin + (size_t)m * DM + 256 * j + 4 * lane);
        if (HAS_F) {
            f32x4 fv[4]; float ss = 0.f;
#pragma unroll
            for (int j = 0; j < 4; ++j) { const u32x2 w = *(const u32x2*)(F + (size_t)m * DM + 256 * j + 4 * lane); fv[j] = (f32x4){bflo(w.x), bfhi(w.x), bflo(w.y), bfhi(w.y)};
                ss += (fv[j][0] * fv[j][0] + fv[j][1] * fv[j][1]) + (fv[j][2] * fv[j][2] + fv[j][3] * fv[j][3]); }
            const float r = coef / sqrtf(wave_sum(ss) * (1.0f / DM) + 1e-6f);
#pragma unroll
            for (int j = 0; j < 4; ++j) hv[j] = hv[j] + fv[j] * gp[j] * r;
        }
        if (WRITE_H) {
#pragma unroll
            for (int j = 0; j < 4; ++j) *(f32x4*)(hout + (size_t)m * DM + 256 * j + 4 * lane) = hv[j];
        }
        if (WRITE_U) {
            float s2 = 0.f;
#pragma unroll
            for (int j = 0; j < 4; ++j) s2 += (hv[j][0] * hv[j][0] + hv[j][1] * hv[j][1]) + (hv[j][2] * hv[j][2] + hv[j][3] * hv[j][3]);
            const float r2 = 1.0f / sqrtf(wave_sum(s2) * (1.0f / DM) + 1e-6f);
#pragma unroll
            for (int j = 0; j < 4; ++j) { const f32x4 uv = hv[j] * gq[j] * r2; u32x2 w; w.x = cvtpk(uv[0], uv[1]); w.y = cvtpk(uv[2], uv[3]); *(u32x2*)(U + (size_t)m * DM + 256 * j + 4 * lane) = w; }
        }
    }
}

__global__ void __launch_bounds__(512, 2) fwd_megakernel(Args a) {
    extern __shared__ __attribute__((aligned(16))) unsigned char lds_raw[];
    LAS unsigned char* lds = (LAS unsigned char*)lds_raw;
    cg::grid_group grid = cg::this_grid();
    const int tid = threadIdx.x, lane = tid & 63, wave = __builtin_amdgcn_readfirstlane(tid >> 6);
    const int G = gridDim.x, bx = blockIdx.x, vcu = (G % 8 == 0) ? (bx % 8) * (G / 8) + bx / 8 : bx;
    const int gw = vcu * 8 + wave, NGW = G * 8;
    unsigned char* ws = a.ws;
    const float* x = (const float*)a.in[0];
    const float* pin = (const float*)a.in[1];
    const int* positions = (const int*)a.in[2];
    float* hbuf = a.out;
    bf16_t* U = (bf16_t*)(ws + WS_U);
    bf16_t* F = (bf16_t*)(ws + WS_F);
    bf16_t* PB = (bf16_t*)(ws + WS_P);
    float* rope = (float*)(ws + WS_ROPE);
    bf16_t* R = (bf16_t*)(ws + WS_R);
    bf16_t* ACT = (bf16_t*)(ws + WS_R + R_ACT);
    float* TMP = (float*)(ws + WS_R + R_TMP);
    bf16_t* MRG = (bf16_t*)(ws + WS_R + R_MRG);
    bf16_t* GSB = (bf16_t*)(ws + WS_R + R_GSB);
    bf16_t* GDF = (bf16_t*)(ws + WS_R + R_GDF);
    bf16_t* OSB = (bf16_t*)(ws + WS_R + R_OSB);
    bf16_t* ODF = (bf16_t*)(ws + WS_R + R_ODF);

    if (PH & 1) {
        LAS float* scr = (LAS float*)(lds + wave * 16384);
        constexpr int I_GU = (DM / 64) * (2 * DFF / 32), I_D = (DFF / 64) * (DM / 32), I_IN = (DM / 64) * (DIN / 32), I_B = (512 / 64) * (DM / 32), I_O = (DM / 64) * (DM / 32), I_PP = (PLE / 64) * (DM / 32);
        constexpr int I_LAYER = 2 * I_GU + 2 * I_D + I_IN + 2 * I_B + 2 * I_O + I_PP;
        for (int it = gw; it < DEPTH * I_LAYER; it += NGW) {
            const int L = it / I_LAYER; int r = it % I_LAYER;
            bf16_t* wl = (bf16_t*)(ws + WS_W + (size_t)L * LAYER_W);
            if (r < I_GU) { transpose_item((const float*)a.in[4] + (size_t)L * DM * 2 * DFF, DM, 2 * DFF, wl + O_WGU1 / 2, 1, scr, r, lane); continue; } r -= I_GU;
            if (r < I_D) { transpose_item((const float*)a.in[5] + (size_t)L * DFF * DM, DFF, DM, wl + O_WD1 / 2, 0, scr, r, lane); continue; } r -= I_D;
            if (r < I_IN) { transpose_item((const float*)a.in[8] + (size_t)L * DM * DIN, DM, DIN, wl + O_WIN / 2, 2, scr, r, lane); continue; } r -= I_IN;
            if (r < I_B) { transpose_item((const float*)a.in[11] + (size_t)L * 512 * DM, 512, DM, wl + O_WBS / 2, 0, scr, r, lane); continue; } r -= I_B;
            if (r < I_B) { transpose_item((const float*)a.in[12] + (size_t)L * 512 * DM, 512, DM, wl + O_WBD / 2, 0, scr, r, lane); continue; } r -= I_B;
            if (r < I_O) { transpose_item((const float*)a.in[13] + (size_t)L * DM * DM, DM, DM, wl + O_WOUT / 2, 0, scr, r, lane); continue; } r -= I_O;
            if (r < I_GU) { transpose_item((const float*)a.in[16] + (size_t)L * DM * 2 * DFF, DM, 2 * DFF, wl + O_WGU2 / 2, 1, scr, r, lane); continue; } r -= I_GU;
            if (r < I_D) { transpose_item((const float*)a.in[17] + (size_t)L * DFF * DM, DFF, DM, wl + O_WD2 / 2, 0, scr, r, lane); continue; } r -= I_D;
            if (r < I_O) { transpose_item((const float*)a.in[20] + (size_t)L * DM * DM, DM, DM, wl + O_WPG / 2, 0, scr, r, lane); continue; } r -= I_O;
            transpose_item((const float*)a.in[21] + (size_t)L * PLE * DM, PLE, DM, wl + O_WPP / 2, 0, scr, r, lane);
        }
        { const size_t n4 = (size_t)DEPTH * M * PLE / 4; const size_t gt = (size_t)vcu * 512 + tid, NT_ = (size_t)G * 512;
          for (size_t i = gt; i < n4; i += NT_) { const f32x4 v = *(const f32x4*)(pin + 4 * i); u32x2 w; w.x = cvtpk(v[0], v[1]); w.y = cvtpk(v[2], v[3]); *(u32x2*)(PB + 4 * i) = w; } }
        { const int gt = vcu * 512 + tid, NT_ = G * 512;
          for (int i = gt; i < M * 32; i += NT_) { const int m = i >> 5, fi = i & 31; const float ang = __fmul_rn((float)positions[m], a.invf[fi]);
              const double rev = (double)ang * 0.15915494309189533577; const float fr = (float)(rev - rint(rev));
              rope[2 * i] = __builtin_amdgcn_cosf(fr); rope[2 * i + 1] = __builtin_amdgcn_sinf(fr); } }
        row_pass<false, false, true>(x, nullptr, nullptr, 0.f, nullptr, (const float*)a.in[3], U, gw, NGW, lane);
    }
    grid.sync();

    for (int L_ = 0; L_ < DEPTH; ++L_) {
        int L = L_; asm volatile("" : "+s"(L));
        const bf16_t* wl = (const bf16_t*)(ws + WS_W + (size_t)L * LAYER_W);
        const size_t go = (size_t)L * DM;
        if (PH & 2) { pg8::Gemm g{U, wl + O_WGU1 / 2, M, 2 * DFF, DM}; pg8::StaticOrder S; S.init(M, 2 * DFF, G, bx); pg8::EpiSwiglu E{ACT};
          pg8::gemm_phase<pg8::EpiSwiglu, pg8::StaticOrder, true, true>(lds, g, S, E); }
        grid.sync();
        if (PH & 4) { pg8::Gemm g{ACT, wl + O_WD1 / 2, M, DM, DFF}; pg8::StaticOrder S; S.init(M, DM, G, bx); pg8::EpiPlain E{F, DM};
          pg8::gemm_phase<pg8::EpiPlain, pg8::StaticOrder, true, true>(lds, g, S, E); }
        grid.sync();
        if (PH & 8) row_pass<true, true, true>(L == 0 ? x : hbuf, hbuf, F, 0.5f, (const float*)a.in[6] + go, (const float*)a.in[7] + go, U, gw, NGW, lane);
        grid.sync();
        if (PH & 16) { pg8::Gemm g{U, wl + O_WIN / 2, M, DIN, DM}; pg8::StaticOrder S; S.init(M, DIN, G, bx); pg8::EpiWin E{R, rope};
          pg8::gemm_phase<pg8::EpiWin, pg8::StaticOrder, true, true>(lds, g, S, E); }
        grid.sync();
        {
            const float* lp = (const float*)a.in[9] + (size_t)L * 256;
            const float s1 = wave_sum(lp[lane] * lp[64 + lane]), s2 = wave_sum(lp[128 + lane] * lp[192 + lane]);
            const float lam_init = a.lam_init[L], lam = expf(s1) - expf(s2) + lam_init;
            const float* subg = (const float*)a.in[10] + (size_t)L * 128;
            const bf16_t* SBQ = R + (R_SBQ / 2); const bf16_t* SBK = R + (R_SBK / 2); const bf16_t* SBV = R + (R_SBV / 2);
            const bf16_t* DFQ = R + (R_DFQ / 2); const bf16_t* DFK = R + (R_DFK / 2); const bf16_t* DFV = R + (R_DFV / 2);
            if (PH & 32) for (int un = vcu; un < 256; un += G) { const int bh = un >> 4, sidx = un & 15;
                att::df_unit(lds, bh >> 2, bh & 3, 31 - sidx, DFQ, DFK, DFV, ODF, lam, 1.0f - lam_init, subg);
                att::df_unit(lds, bh >> 2, bh & 3, sidx, DFQ, DFK, DFV, ODF, lam, 1.0f - lam_init, subg); }
            if (PH & 64) for (int un = vcu; un < 512; un += G) { const int bh = un >> 4, qb = un & 15;
                att::sb_unit(lds, bh >> 3, bh & 7, qb, SBQ, SBK, SBV, OSB); }
        }
        grid.sync();
        if (PH & 128) { pg8::Gemm g{OSB, wl + O_WBS / 2, M, DM, 512}; pg8::StaticOrder S; S.init(M, DM, G, bx); pg8::EpiTwo<0> E{TMP, GSB, nullptr};
          pg8::gemm_phase<pg8::EpiTwo<0>, pg8::StaticOrder, true, true>(lds, g, S, E); }
        if (PH & 128) { pg8::Gemm g{ODF, wl + O_WBD / 2, M, DM, 512}; pg8::StaticOrder S; S.init(M, DM, G, bx); pg8::EpiTwo<1> E{TMP, GDF, MRG};
          pg8::gemm_phase<pg8::EpiTwo<1>, pg8::StaticOrder, true, true>(lds, g, S, E); }
        grid.sync();
        if (PH & 4) { pg8::Gemm g{MRG, wl + O_WOUT / 2, M, DM, DM}; pg8::StaticOrder S; S.init(M, DM, G, bx); pg8::EpiPlain E{F, DM};
          pg8::gemm_phase<pg8::EpiPlain, pg8::StaticOrder, true, true>(lds, g, S, E); }
        grid.sync();
        row_pass<true, true, true>(hbuf, hbuf, F, 1.0f, (const float*)a.in[14] + go, (const float*)a.in[15] + go, U, gw, NGW, lane);
        grid.sync();
        if (PH & 2) { pg8::Gemm g{U, wl + O_WGU2 / 2, M, 2 * DFF, DM}; pg8::StaticOrder S; S.init(M, 2 * DFF, G, bx); pg8::EpiSwiglu E{ACT};
          pg8::gemm_phase<pg8::EpiSwiglu, pg8::StaticOrder, true, true>(lds, g, S, E); }
        grid.sync();
        if (PH & 4) { pg8::Gemm g{ACT, wl + O_WD2 / 2, M, DM, DFF}; pg8::StaticOrder S; S.init(M, DM, G, bx); pg8::EpiPlain E{F, DM};
          pg8::gemm_phase<pg8::EpiPlain, pg8::StaticOrder, true, true>(lds, g, S, E); }
        grid.sync();
        row_pass<true, true, true>(hbuf, hbuf, F, 0.5f, (const float*)a.in[18] + go, (const float*)a.in[19] + go, U, gw, NGW, lane);
        grid.sync();
        if (PH & 256) { pg8::Gemm g{U, wl + O_WPG / 2, M, DM, DM}; pg8::StaticOrder S; S.init(M, DM, G, bx); pg8::EpiTwo<2> E{TMP, nullptr, nullptr};
          pg8::gemm_phase<pg8::EpiTwo<2>, pg8::StaticOrder, true, true>(lds, g, S, E); }
        if (PH & 256) { pg8::Gemm g{PB + (size_t)L * M * PLE, wl + O_WPP / 2, M, DM, PLE}; pg8::StaticOrder S; S.init(M, DM, G, bx); pg8::EpiTwo<3> E{TMP, nullptr, F};
          pg8::gemm_phase<pg8::EpiTwo<3>, pg8::StaticOrder, true, true>(lds, g, S, E); }
        grid.sync();
        if (L + 1 < DEPTH) row_pass<true, true, true>(hbuf, hbuf, F, 1.0f, (const float*)a.in[22] + go, (const float*)a.in[3] + go + DM, U, gw, NGW, lane);
        else row_pass<true, true, false>(hbuf, hbuf, F, 1.0f, (const float*)a.in[22] + go, nullptr, nullptr, gw, NGW, lane);
        if (L + 1 < DEPTH) grid.sync();
    }
}

extern "C" void kernel_launch(void* const* d_in, const int* in_sizes, int n_in, void* d_out, int out_size, void* d_ws, size_t ws_size, hipStream_t stream) {
    static int grid_blocks = 0;
    if (grid_blocks == 0) {
        if (n_in != 23 || out_size != M * DM || ws_size < WS_END) { fprintf(stderr, "kernel_launch: unexpected shapes (n_in %d out %d ws %zu)\n", n_in, out_size, ws_size); grid_blocks = -1; return; }
        int dev = 0, cus = 0, per_cu = 0;
        hipGetDevice(&dev);
        hipDeviceGetAttribute(&cus, hipDeviceAttributeMultiprocessorCount, dev);
        if (hipFuncSetAttribute((const void*)fwd_megakernel, hipFuncAttributeMaxDynamicSharedMemorySize, LDS_BYTES) != hipSuccess) { fprintf(stderr, "kernel_launch: hipFuncSetAttribute failed\n"); grid_blocks = -1; return; }
        if (hipOccupancyMaxActiveBlocksPerMultiprocessor(&per_cu, (const void*)fwd_megakernel, 512, LDS_BYTES) != hipSuccess || per_cu < 1) { fprintf(stderr, "kernel_launch: occupancy query failed (%d)\n", per_cu); per_cu = 1; }
        (void)hipGetLastError();
        grid_blocks = cus * per_cu;
    }
    if (grid_blocks < 0) return;
    Args a{};
    for (int i = 0; i < 23; ++i) a.in[i] = d_in[i];
    a.out = (float*)d_out; a.ws = (unsigned char*)d_ws;
    for (int i = 0; i < 32; ++i) a.invf[i] = powf(10000.0f, -(float)i / 32.0f);
    for (int i = 0; i < 4; ++i) a.lam_init[i] = (float)(0.8 - 0.6 * exp(-0.3 * (double)i));
    void* args[] = {&a};
    hipError_t e = hipLaunchCooperativeKernel((const void*)fwd_megakernel, dim3(grid_blocks), dim3(512), args, LDS_BYTES, stream);
    if (e != hipSuccess) fprintf(stderr, "cooperative launch failed: %s (grid %d)\n", hipGetErrorString(e), grid_blocks);
}
```

```cpp
#include <hip/hip_runtime.h>
#include <hip/hip_cooperative_groups.h>
#include <cstdio>
#include <cstdint>
#include <cmath>
namespace cg = cooperative_groups;
namespace pg8 {
#define PG8_LAS __attribute__((address_space(3)))
typedef unsigned short bf16_t;
typedef short bf16x8 __attribute__((ext_vector_type(8)));
typedef float f32x4 __attribute__((ext_vector_type(4)));
typedef unsigned u32x4 __attribute__((ext_vector_type(4)));
constexpr int BM = 256, BK = 64, HALF = 128, HTB = HALF * BK * 2  , STAGE_BYTES = 8 * HTB, NXCD = 8, WGM = 8;

__host__ __device__ __forceinline__ int lds_byte(int r, int c) { const int st = (r >> 4) * 2 + (c >> 5), rr = r & 15, cc = c & 31, ob = rr * 64 + cc * 2; return st * 1024 + (ob ^ (((ob >> 9) & 1) << 5)); }
__host__ __device__ __forceinline__ void stage_rc(int b, int& R, int& C) { const int st = b / 1024, sb = b % 1024, swz = sb ^ (((sb >> 9) & 1) << 5); R = (st >> 1) * 16 + swz / 64; C = (st & 1) * 32 + (swz % 64) / 2; }
__host__ __device__ __forceinline__ int perm32(int rho) { const int n = rho >> 4, i = rho & 15; return 8 * (i >> 2) + 4 * n + (i & 3); }

struct Unit { int pm, pn; };
struct Gemm { const bf16_t* A; const bf16_t* Bt; int M, N, K; };

struct StaticOrder {
    int nM, nN, nwg, G, c;
    __host__ __device__ void init(int M, int N, int G_, int c_) { nM = M / BM; nN = N / BM; nwg = nM * nN; G = G_; c = c_; }
    __host__ __device__ bool next(int i, Unit& u) const {
        const long L = (long)i * G + c; if (L >= nwg) return false;
        int wgid = (int)L; { const int q = nwg / NXCD, r = nwg % NXCD, xcd = wgid % NXCD, off = wgid / NXCD; wgid = (xcd < r ? xcd * (q + 1) : r * (q + 1) + (xcd - r) * q) + off; }
        const int nig = WGM * nN, gid = wgid / nig, fm = gid * WGM, gsz = (nM - fm) < WGM ? (nM - fm) : WGM;
        u.pm = fm + ((wgid % nig) % gsz); u.pn = (wgid % nig) / gsz; return true;
    }
    __device__ __forceinline__ void a_ready(const Unit&) const {}
    __device__ __forceinline__ void done(const Unit&) const {}
};

}
namespace pg8 {
template <class Epi, class Sched, bool ALIGN_EPI = false, bool SP2 = false>
__device__ __forceinline__ void gemm_phase(PG8_LAS unsigned char* lds, const Gemm g, const Sched& S, const Epi& E) {
    int tid_ = threadIdx.x; asm volatile("" : "+v"(tid_));
    const int tid = tid_, wid = __builtin_amdgcn_readfirstlane(tid >> 6), lane = tid & 63, wr = wid >> 2, wc = wid & 3, fr = lane & 15, fq = lane >> 4;
    const int K = g.K, nt = K / BK;
    unsigned voffA[2], voffB[2];
#pragma unroll
    for (int i = 0; i < 2; ++i) { int R, C; stage_rc(tid * 16 + i * 8192, R, C); const int Rb = Epi::PERM ? ((R & ~31) + perm32(R & 31)) : R;
        voffA[i] = (unsigned)(R * K + C) * 2u; voffB[i] = (unsigned)(Rb * K + C) * 2u; }
    const size_t kstep = (size_t)(BK * 2);
    const size_t hstep = (size_t)HALF * K * 2;
    const size_t tstep = 2 * hstep;
    const unsigned ldsw = (unsigned)wid * 1024u;
    const int aoff = lds_byte(wr * 64 + fr, fq * 8), boff = lds_byte(wc * 32 + fr, fq * 8);
#define PG8_SA(b, h) (((b) * 2 + (h)) * HTB)
#define PG8_SB(b, h) ((4 + (b) * 2 + (h)) * HTB)
#define PG8_STAGE(bufoff, gbase, voff) do { _Pragma("unroll") for (int _i = 0; _i < 2; ++_i) \
        __builtin_amdgcn_global_load_lds((const unsigned*)((const char*)(gbase) + (voff)[_i]), (PG8_LAS unsigned*)(lds + (bufoff) + ldsw + _i * 8192), 16, 0, 0); } while (0)
#define PG8_LDA(dst, b, h) do { _Pragma("unroll") for (int m = 0; m < 4; ++m) _Pragma("unroll") for (int k = 0; k < 2; ++k) dst[m][k] = *(const PG8_LAS bf16x8*)(lds + PG8_SA(b, h) + aoff + m * 2048 + k * 1024); } while (0)
#define PG8_LDB(dst, b, h) do { _Pragma("unroll") for (int n = 0; n < 2; ++n) _Pragma("unroll") for (int k = 0; k < 2; ++k) dst[n][k] = *(const PG8_LAS bf16x8*)(lds + PG8_SB(b, h) + boff + n * 2048 + k * 1024); } while (0)
#define PG8_MMA(ai, bj, At, Bt) do { __builtin_amdgcn_s_setprio(1); _Pragma("unroll") for (int m = 0; m < 4; ++m) _Pragma("unroll") for (int n = 0; n < 2; ++n) _Pragma("unroll") for (int k = 0; k < 2; ++k) \
        acc[ai][bj][m][n] = __builtin_amdgcn_mfma_f32_16x16x32_bf16(Bt[n][k], At[m][k], acc[ai][bj][m][n], 0, 0, 0); __builtin_amdgcn_s_setprio(0); } while (0)
#define PG8_WAIT_V(n) asm volatile("s_waitcnt vmcnt(" #n ")" ::: "memory")
#define PG8_WAIT_L(n) asm volatile("s_waitcnt lgkmcnt(" #n ")" ::: "memory")
#define PG8_BAR __builtin_amdgcn_s_barrier()
#define PG8_SCHED __builtin_amdgcn_sched_barrier(0)
    Unit cur, nxt; int ui = 0;
    if (!S.next(0, cur)) return;
    f32x4 acc[2][2][4][2];
#pragma unroll
    for (int a = 0; a < 2; ++a)
#pragma unroll
        for (int b = 0; b < 2; ++b)
#pragma unroll
            for (int m = 0; m < 4; ++m)
#pragma unroll
                for (int n = 0; n < 2; ++n) acc[a][b][m][n] = (f32x4){0.f, 0.f, 0.f, 0.f};
    bf16x8 At[4][2], B0[2][2], B1[2][2];
    const char* cA = (const char*)g.A + (size_t)cur.pm * tstep; const char* cB = (const char*)g.Bt + (size_t)cur.pn * tstep;
    S.a_ready(cur);
    if constexpr (SP2) {
        PG8_STAGE(PG8_SB(0, 0), cB, voffB); PG8_STAGE(PG8_SB(0, 1), cB + hstep, voffB); PG8_STAGE(PG8_SA(0, 0), cA, voffA); PG8_STAGE(PG8_SA(0, 1), cA + hstep, voffA);
        if (wr == 1) PG8_BAR;
        PG8_WAIT_V(2); PG8_BAR;
        PG8_STAGE(PG8_SB(1, 0), cB + kstep, voffB); PG8_STAGE(PG8_SA(1, 0), cA + kstep, voffA); PG8_STAGE(PG8_SB(1, 1), cB + hstep + kstep, voffB);
        PG8_WAIT_V(6); PG8_BAR;
    } else {
        PG8_STAGE(PG8_SB(0, 0), cB, voffB); PG8_STAGE(PG8_SA(0, 0), cA, voffA); PG8_STAGE(PG8_SB(0, 1), cB + hstep, voffB); PG8_STAGE(PG8_SA(0, 1), cA + hstep, voffA);
        if (wr == 1) PG8_BAR;
        PG8_WAIT_V(4); PG8_BAR;
        PG8_STAGE(PG8_SB(1, 0), cB + kstep, voffB); PG8_STAGE(PG8_SA(1, 0), cA + kstep, voffA); PG8_STAGE(PG8_SB(1, 1), cB + hstep + kstep, voffB);
        PG8_WAIT_V(6); PG8_BAR;
    }
    for (;;) {
        const bool has_next = S.next(ui + 1, nxt);
        const char* nA = has_next ? (const char*)g.A + (size_t)nxt.pm * tstep : cA; const char* nB = has_next ? (const char*)g.Bt + (size_t)nxt.pn * tstep : cB;
#pragma unroll 1
        for (int t = 0; t < nt; t += 2) {
            const bool last = (t == nt - 2);
            const char* a1 = cA + (size_t)(t + 1) * kstep;
            const char* a2 = last ? nA : cA + (size_t)(t + 2) * kstep; const char* b2 = last ? nB : cB + (size_t)(t + 2) * kstep;
            const char* a3 = a2 + kstep; const char* b3 = b2 + kstep;
            if (last && has_next) S.a_ready(nxt);
            if constexpr (SP2) {
            PG8_LDB(B0, 0, 0); PG8_LDB(B1, 0, 1); PG8_SCHED; PG8_LDA(At, 0, 0); PG8_STAGE(PG8_SA(1, 1), a1 + hstep, voffA);
            PG8_WAIT_V(8); PG8_WAIT_L(0); PG8_BAR; PG8_MMA(0, 0, At, B0); PG8_MMA(0, 1, At, B1); PG8_BAR; PG8_SCHED;
            PG8_LDA(At, 0, 1); PG8_STAGE(PG8_SB(0, 0), b2, voffB); PG8_STAGE(PG8_SB(0, 1), b2 + hstep, voffB); PG8_STAGE(PG8_SA(0, 0), a2, voffA);
            PG8_WAIT_V(8); PG8_WAIT_L(0); PG8_BAR; PG8_MMA(1, 0, At, B0); PG8_MMA(1, 1, At, B1); PG8_BAR; PG8_SCHED;
            PG8_LDB(B0, 1, 0); PG8_LDB(B1, 1, 1); PG8_SCHED; PG8_LDA(At, 1, 0); PG8_STAGE(PG8_SA(0, 1), a2 + hstep, voffA);
            PG8_WAIT_V(8); PG8_WAIT_L(0); PG8_BAR; PG8_MMA(0, 0, At, B0); PG8_MMA(0, 1, At, B1); PG8_BAR; PG8_SCHED;
            PG8_LDA(At, 1, 1); PG8_STAGE(PG8_SB(1, 0), b3, voffB); PG8_STAGE(PG8_SB(1, 1), b3 + hstep, voffB); PG8_STAGE(PG8_SA(1, 0), a3, voffA);
            PG8_WAIT_V(8); PG8_WAIT_L(0); PG8_BAR; PG8_MMA(1, 0, At, B0); PG8_MMA(1, 1, At, B1); PG8_BAR; PG8_SCHED;
            } else {
            PG8_LDB(B0, 0, 0); PG8_SCHED; PG8_LDA(At, 0, 0); PG8_STAGE(PG8_SA(1, 1), a1 + hstep, voffA);
            PG8_WAIT_L(8); PG8_BAR; PG8_WAIT_L(0); PG8_MMA(0, 0, At, B0); PG8_BAR; PG8_SCHED;
            PG8_LDB(B1, 0, 1); PG8_STAGE(PG8_SB(0, 0), b2, voffB);
            PG8_BAR; PG8_WAIT_L(0); PG8_MMA(0, 1, At, B1); PG8_BAR;
            PG8_LDA(At, 0, 1); PG8_STAGE(PG8_SA(0, 0), a2, voffA);
            PG8_BAR; PG8_WAIT_L(0); PG8_MMA(1, 0, At, B0); PG8_BAR; PG8_SCHED;
            PG8_STAGE(PG8_SB(0, 1), b2 + hstep, voffB);
            PG8_WAIT_V(6); PG8_BAR; PG8_MMA(1, 1, At, B1); PG8_BAR;
            PG8_LDB(B0, 1, 0); PG8_SCHED; PG8_LDA(At, 1, 0); PG8_STAGE(PG8_SA(0, 1), a2 + hstep, voffA);
            PG8_WAIT_L(8); PG8_BAR; PG8_WAIT_L(0); PG8_MMA(0, 0, At, B0); PG8_BAR; PG8_SCHED;
            PG8_LDB(B1, 1, 1); PG8_STAGE(PG8_SB(1, 0), b3, voffB);
            PG8_BAR; PG8_WAIT_L(0); PG8_MMA(0, 1, At, B1); PG8_BAR;
            PG8_LDA(At, 1, 1); PG8_STAGE(PG8_SA(1, 0), a3, voffA);
            PG8_BAR; PG8_WAIT_L(0); PG8_MMA(1, 0, At, B0); PG8_BAR; PG8_SCHED;
            PG8_STAGE(PG8_SB(1, 1), b3 + hstep, voffB);
            PG8_WAIT_V(6); PG8_BAR; PG8_MMA(1, 1, At, B1); PG8_BAR;
            }
        }
        if constexpr (ALIGN_EPI) { if (wr == 0) PG8_BAR; }
        if constexpr (!Epi::AFTER_DRAIN) { E(acc, cur, wr, wc, fr, fq); S.done(cur); }
        if (!has_next) break;
#pragma unroll
        for (int a = 0; a < 2; ++a)
#pragma unroll
            for (int b = 0; b < 2; ++b)
#pragma unroll
                for (int m = 0; m < 4; ++m)
#pragma unroll
                    for (int n = 0; n < 2; ++n) acc[a][b][m][n] = (f32x4){0.f, 0.f, 0.f, 0.f};
        cur = nxt; cA = nA; cB = nB; ++ui;
        if constexpr (ALIGN_EPI) { if (wr == 1) PG8_BAR; }
    }
    PG8_WAIT_V(0);
    if constexpr (!ALIGN_EPI) { if (wr == 0) PG8_BAR; }
    PG8_BAR;
    if constexpr (Epi::AFTER_DRAIN) { E.fused(acc, cur, wr, wc, fr, fq, lds, wid, lane); S.done(cur); }
#undef PG8_SA
#undef PG8_SB
#undef PG8_STAGE
#undef PG8_LDA
#undef PG8_LDB
#undef PG8_MMA
#undef PG8_WAIT_V
#undef PG8_WAIT_L
#undef PG8_BAR
#undef PG8_SCHED
}
}
#define LAS __attribute__((address_space(3)))
typedef unsigned short bf16_t;
typedef short bf16x8 __attribute__((ext_vector_type(8)));
typedef short s16x4 __attribute__((ext_vector_type(4)));
typedef float f32x4 __attribute__((ext_vector_type(4)));
typedef float f32x16 __attribute__((ext_vector_type(16)));
typedef unsigned u32x4 __attribute__((ext_vector_type(4)));
typedef unsigned u32x2 __attribute__((ext_vector_type(2)));

constexpr int NB = 4, SEQ = 4096, DM = 1024, DFF = 2816, DIN = 5120, DEPTH = 4, PLE = 256;
constexpr int M = NB * SEQ;
constexpr size_t MiB = 1u << 20;
constexpr size_t SZ_WGU = (size_t)2 * DFF * DM * 2, SZ_WD = (size_t)DM * DFF * 2, SZ_WIN = (size_t)DIN * DM * 2, SZ_WB = (size_t)DM * 512 * 2, SZ_WO = (size_t)DM * DM * 2, SZ_WPP = (size_t)DM * PLE * 2;
constexpr size_t O_WGU1 = 0, O_WD1 = O_WGU1 + SZ_WGU, O_WIN = O_WD1 + SZ_WD, O_WBS = O_WIN + SZ_WIN, O_WBD = O_WBS + SZ_WB, O_WOUT = O_WBD + SZ_WB, O_WGU2 = O_WOUT + SZ_WO,
                 O_WD2 = O_WGU2 + SZ_WGU, O_WPG = O_WD2 + SZ_WD, O_WPP = O_WPG + SZ_WO, LAYER_W = O_WPP + SZ_WPP;
constexpr size_t WS_CTL = 198 * MiB, CTL_BYTES = 16384; constexpr int XCD_BAR_WORDS_C = 3456;
constexpr size_t WS_W = 0, WS_U = 200 * MiB, WS_F = 232 * MiB, WS_P = 264 * MiB, WS_ROPE = 296 * MiB, WS_R = 300 * MiB, WS_END = 492 * MiB;
static_assert(LAYER_W * DEPTH <= WS_CTL && XCD_BAR_WORDS_C * 4 <= CTL_BYTES, "weights fit");
constexpr int LDS_MISC = 131072;
constexpr size_t R_SBQ = 0, R_SBK = 16 * MiB, R_SBV = 32 * MiB, R_DFQ = 48 * MiB, R_DFK = 64 * MiB, R_DFV = 80 * MiB, R_GSB = 96 * MiB, R_GDF = 128 * MiB, R_OSB = 160 * MiB, R_ODF = 176 * MiB;
constexpr size_t R_TMP = 0, R_MRG = 64 * MiB, R_ACT = 0;
constexpr int LDS_BYTES = 147456;
#ifndef PH
#define PH 0xffff
#endif
#ifndef SYNC_REP
#define SYNC_REP 1
#endif
#ifndef ATT_REP
#define ATT_REP 1
#endif
#ifndef ROW_REP
#define ROW_REP 1
#endif
#define GRID_SYNC() do { for (int r_ = 0; r_ < SYNC_REP; ++r_) xcd_barrier(bar); } while (0)

struct Args {
    const void* in[23];
    float* out;
    unsigned char* ws;
    float invf[32];
    float lam_init[4];
};
static_assert(sizeof(Args) % 8 == 0, "no tail padding");

typedef float f32x2_t __attribute__((ext_vector_type(2))); typedef __bf16 bf16x2_t __attribute__((ext_vector_type(2)));
__device__ __forceinline__ unsigned cvtpk(float lo, float hi) { f32x2_t v = {lo, hi}; bf16x2_t b = __builtin_convertvector(v, bf16x2_t); return __builtin_bit_cast(unsigned, b); }
__device__ __forceinline__ float bflo(unsigned w) { return __uint_as_float(w << 16); }
__device__ __forceinline__ float bfhi(unsigned w) { return __uint_as_float(w & 0xffff0000u); }
__device__ __forceinline__ float wave_sum(float v) {
#pragma unroll
    for (int o = 1; o < 64; o <<= 1) v += __shfl_xor(v, o);
    return v;
}
__device__ __forceinline__ float sigmoidf_(float x) { return __builtin_amdgcn_rcpf(1.0f + __expf(-x)); }

namespace pg8 {
typedef f32x4 (acc_t)[2][2][4][2];
__device__ __forceinline__ u32x4 pack8(const f32x4 v0, const f32x4 v1) { u32x4 w; w.x = cvtpk(v0[0], v0[1]); w.y = cvtpk(v0[2], v0[3]); w.z = cvtpk(v1[0], v1[1]); w.w = cvtpk(v1[2], v1[3]); return w; }
__device__ __forceinline__ void unpack8(const u32x4 w, f32x4& v0, f32x4& v1) { v0 = (f32x4){bflo(w.x), bfhi(w.x), bflo(w.y), bfhi(w.y)}; v1 = (f32x4){bflo(w.z), bfhi(w.z), bflo(w.w), bfhi(w.w)}; }

struct EpiPlain {
    static constexpr bool PERM = true, AFTER_DRAIN = false;
    bf16_t* O; int ldc;
    __device__ __forceinline__ void operator()(const f32x4 (&acc)[2][2][4][2], const Unit& u, int wr, int wc, int fr, int fq) const {
        const int row0 = u.pm * BM + wr * 64 + fr, col0 = u.pn * BM + wc * 32 + 8 * fq;
#pragma unroll
        for (int ai = 0; ai < 2; ++ai)
#pragma unroll
            for (int m = 0; m < 4; ++m) { bf16_t* rowp = O + (size_t)(row0 + ai * HALF + m * 16) * ldc + col0;
#pragma unroll
                for (int bj = 0; bj < 2; ++bj) *(u32x4*)(rowp + bj * HALF) = pack8(acc[ai][bj][m][0], acc[ai][bj][m][1]); }
    }
};
struct EpiSwiglu {
    static constexpr bool PERM = true, AFTER_DRAIN = false;
    bf16_t* O;
    __device__ __forceinline__ void operator()(const f32x4 (&acc)[2][2][4][2], const Unit& u, int wr, int wc, int fr, int fq) const {
        const int row0 = u.pm * BM + wr * 64 + fr, col0 = u.pn * HALF + wc * 32 + 8 * fq;
#pragma unroll
        for (int ai = 0; ai < 2; ++ai)
#pragma unroll
            for (int m = 0; m < 4; ++m) { bf16_t* rowp = O + (size_t)(row0 + ai * HALF + m * 16) * DFF + col0;
                f32x4 o[2];
#pragma unroll
                for (int n = 0; n < 2; ++n) { const f32x4 g = acc[ai][0][m][n], uu = acc[ai][1][m][n];
#pragma unroll
                    for (int e = 0; e < 4; ++e) o[n][e] = g[e] * sigmoidf_(g[e]) * uu[e]; }
                *(u32x4*)rowp = pack8(o[0], o[1]); }
    }
};
struct EpiWin {
    static constexpr bool PERM = true, AFTER_DRAIN = false;
    bf16_t* R; const float* rope;
    __device__ __forceinline__ void operator()(const f32x4 (&acc)[2][2][4][2], const Unit& u, int wr, int wc, int fr, int fq) const {
        const int pn = u.pn, row0 = u.pm * BM + wr * 64 + fr, cl = wc * 32 + 8 * fq;
        if (pn < 12) {
            const int sec = pn >> 1;
            bf16_t* base = R + (size_t)sec * ((size_t)M * 512) + (pn & 1) * 256 + cl;
            const float sc = (sec == 0) ? 0.125f : ((sec == 3) ? 0.125f * 1.4426950408889634f : 1.0f);
            const bool rp = (sec == 3) || (sec == 4);
#pragma unroll
            for (int ai = 0; ai < 2; ++ai)
#pragma unroll
                for (int m = 0; m < 4; ++m) { const int row = row0 + ai * HALF + m * 16;
                    f32x4 cs0 = {1.f, 0.f, 1.f, 0.f}, cs1 = {1.f, 0.f, 1.f, 0.f};
                    if (rp) { const float* rt = rope + (size_t)row * 64 + (16 * (wc & 1) + 4 * fq) * 2; cs0 = *(const f32x4*)rt; cs1 = *(const f32x4*)(rt + 4); }
                    const f32x4 cc = {cs0[0], cs0[2], cs1[0], cs1[2]}, ss = {cs0[1], cs0[3], cs1[1], cs1[3]};
#pragma unroll
                    for (int bj = 0; bj < 2; ++bj) { const f32x4 x1 = acc[ai][bj][m][0] * sc, x2 = acc[ai][bj][m][1] * sc;
                        const f32x4 y1 = x1 * cc - x2 * ss, y2 = x2 * cc + x1 * ss;
                        *(u32x4*)(base + (size_t)row * 512 + bj * HALF) = pack8(y1, y2); } }
        } else {
            const int t = pn - 12;
            bf16_t* base = R + (size_t)6 * ((size_t)M * 512) + (size_t)(t >> 2) * ((size_t)M * 1024) + (t & 3) * 256 + cl;
#pragma unroll
            for (int ai = 0; ai < 2; ++ai)
#pragma unroll
                for (int m = 0; m < 4; ++m) { const int row = row0 + ai * HALF + m * 16;
#pragma unroll
                    for (int bj = 0; bj < 2; ++bj) { f32x4 v0 = acc[ai][bj][m][0], v1 = acc[ai][bj][m][1];
#pragma unroll
                        for (int e = 0; e < 4; ++e) { v0[e] = sigmoidf_(v0[e]); v1[e] = sigmoidf_(v1[e]); }
                        *(u32x4*)(base + (size_t)row * 1024 + bj * HALF) = pack8(v0, v1); } }
        }
    }
};
template <int MODE> struct EpiTwo {
    static constexpr bool PERM = true, AFTER_DRAIN = false;
    float* tmp; const bf16_t* G; bf16_t* O;
    __device__ __forceinline__ void operator()(const f32x4 (&acc)[2][2][4][2], const Unit& u, int wr, int wc, int fr, int fq) const {
        const int row0 = u.pm * BM + wr * 64 + fr, col0 = u.pn * BM + wc * 32 + 8 * fq;
#pragma unroll
        for (int ai = 0; ai < 2; ++ai)
#pragma unroll
            for (int m = 0; m < 4; ++m) { const size_t off = (size_t)(row0 + ai * HALF + m * 16) * 1024 + col0;
#pragma unroll
                for (int bj = 0; bj < 2; ++bj) { f32x4 v0 = acc[ai][bj][m][0], v1 = acc[ai][bj][m][1]; const size_t o2 = off + bj * HALF;
                    if (MODE == 0 || MODE == 1) { f32x4 g0, g1; unpack8(*(const u32x4*)(G + o2), g0, g1); v0 = v0 * g0; v1 = v1 * g1; }
                    if (MODE == 2) {
#pragma unroll
                        for (int e = 0; e < 4; ++e) { v0[e] = sigmoidf_(v0[e]); v1[e] = sigmoidf_(v1[e]); } }
                    if (MODE == 0 || MODE == 2) { *(f32x4*)(tmp + o2) = v0; *(f32x4*)(tmp + o2 + 4) = v1; }
                    else { const f32x4 t0 = *(const f32x4*)(tmp + o2), t1 = *(const f32x4*)(tmp + o2 + 4);
                        if (MODE == 1) { v0 = v0 + t0; v1 = v1 + t1; } else { v0 = v0 * t0; v1 = v1 * t1; }
                        *(u32x4*)(O + o2) = pack8(v0, v1); } } }
    }
};
}

namespace att {
#define MFMA32(a, b, c) __builtin_amdgcn_mfma_f32_32x32x16_bf16((a), (b), (c), 0, 0, 0)
typedef short v4i16_t __attribute__((ext_vector_type(4)));
__device__ __forceinline__ int crow(int r, int hi) { return (r & 3) + 8 * (r >> 2) + 4 * hi; }
__device__ __forceinline__ s16x4 vtr(LAS const unsigned char* p) { return __builtin_bit_cast(s16x4, __builtin_amdgcn_ds_read_tr16_b64_v4i16((LAS v4i16_t*)p)); }
__device__ __forceinline__ bf16x8 cat8(s16x4 a, s16x4 b) { return (bf16x8){a[0], a[1], a[2], a[3], b[0], b[1], b[2], b[3]}; }
__device__ __forceinline__ bf16x8 packp(const f32x16& p, int s) { u32x4 w; w.x = cvtpk(p[8 * s], p[8 * s + 1]); w.y = cvtpk(p[8 * s + 2], p[8 * s + 3]); w.z = cvtpk(p[8 * s + 4], p[8 * s + 5]); w.w = cvtpk(p[8 * s + 6], p[8 * s + 7]); return __builtin_bit_cast(bf16x8, w); }

__device__ __forceinline__ void df_unit(LAS unsigned char* lds, int b, int h, int qb, const bf16_t* __restrict__ Q, const bf16_t* __restrict__ K, const bf16_t* __restrict__ V, bf16_t* __restrict__ O,
                                        float lam, float oscale, const float* __restrict__ subg) {
    int tid_ = threadIdx.x; asm volatile("" : "+v"(tid_));
    const int tid = tid_, lane = tid & 63, wid = __builtin_amdgcn_readfirstlane(tid >> 6), r32 = lane & 31, hi = lane >> 5;
    const int c = wid >> 2, wq = wid & 3;
    const size_t rowbase = (size_t)b * SEQ;
    const int q0 = qb * 128, qw0 = q0 + 32 * wq, NT = (q0 + 128) / 64;
    const bf16_t* kg = K + (rowbase + lane) * 512 + h * 128 + wid * 8;
    const bf16_t* vg = V + (rowbase + 16 * (wid & 3) + (lane >> 2)) * 512 + h * 128 + (wid >> 2) * 32 + (lane & 3) * 8;
    u32x4 rk1, rk2, rv0, rv1;
#define DF_LOAD(t) do { const size_t off_ = (size_t)(t) * 64 * 512; rk1 = *(const u32x4*)(kg + off_); rk2 = *(const u32x4*)(kg + off_ + 64); rv0 = *(const u32x4*)(vg + off_); rv1 = *(const u32x4*)(vg + off_ + 64); } while (0)
#define DF_STORE(s) do { LAS unsigned char* sb_ = lds + (s) * 32768 + wid * 1024 + lane * 16; *(LAS u32x4*)(sb_) = rk1; *(LAS u32x4*)(sb_ + 8192) = rk2; *(LAS u32x4*)(sb_ + 16384) = rv0; *(LAS u32x4*)(sb_ + 24576) = rv1; } while (0)
    bf16x8 qr[4];
    { const bf16_t* qp = Q + (rowbase + qw0 + r32) * 512 + h * 128 + c * 64 + hi * 8;
#pragma unroll
      for (int d0 = 0; d0 < 4; ++d0) qr[d0] = *(const bf16x8*)(qp + d0 * 16); }
    float m_run = -1e30f, l_run = 0.f;
    f32x16 o[4];
#pragma unroll
    for (int d = 0; d < 4; ++d) o[d] = (f32x16){};
    DF_LOAD(0); DF_STORE(0); __syncthreads();
    for (int kt = 0; kt < NT; ++kt) {
        const int s = kt & 1;
        if (kt + 1 < NT) DF_LOAD(kt + 1);
        if (64 * kt <= qw0 + 31) {
            LAS const unsigned char* kb = lds + s * 32768 + c * 8192 + hi * 1024 + r32 * 16;
            f32x16 p0 = (f32x16){}, p1 = (f32x16){};
#pragma unroll
            for (int d0 = 0; d0 < 4; ++d0) { const bf16x8 a0 = *(LAS const bf16x8*)(kb + d0 * 2048), a1 = *(LAS const bf16x8*)(kb + d0 * 2048 + 512);
                p0 = MFMA32(a0, qr[d0], p0); p1 = MFMA32(a1, qr[d0], p1); }
            if (64 * kt + 63 > qw0) { const int q = qw0 + r32, kb0 = 64 * kt + 4 * hi;
#pragma unroll
                for (int r = 0; r < 16; ++r) { const int key = kb0 + (r & 3) + 8 * (r >> 2); if (key > q) p0[r] = -INFINITY; if (key + 32 > q) p1[r] = -INFINITY; } }
            float mx = fmaxf(p0[0], p1[0]);
#pragma unroll
            for (int r = 1; r < 16; ++r) mx = fmaxf(mx, fmaxf(p0[r], p1[r]));
            mx = fmaxf(mx, __shfl_xor(mx, 32));
            const float mn = fmaxf(m_run, mx), sc = __builtin_amdgcn_exp2f(m_run - mn);
            m_run = mn;
            float rs = 0.f;
#pragma unroll
            for (int r = 0; r < 16; ++r) { p0[r] = __builtin_amdgcn_exp2f(p0[r] - mn); p1[r] = __builtin_amdgcn_exp2f(p1[r] - mn); rs += p0[r] + p1[r]; }
            rs += __shfl_xor(rs, 32);
            l_run = l_run * sc + rs;
#pragma unroll
            for (int r = 0; r < 16; ++r) { const float f = __shfl(sc, crow(r, hi));
#pragma unroll
                for (int d = 0; d < 4; ++d) o[d][r] *= f; }
            bf16x8 pa[4]; pa[0] = packp(p0, 0); pa[1] = packp(p0, 1); pa[2] = packp(p1, 0); pa[3] = packp(p1, 1);
            LAS const unsigned char* vb = lds + s * 32768 + 16384 + ((lane >> 4) & 1) * 32 + (lane & 3) * 8 + (4 * hi + ((lane & 15) >> 2)) * 64;
#pragma unroll
            for (int d = 0; d < 4; ++d)
#pragma unroll
                for (int ks = 0; ks < 4; ++ks) { const s16x4 lo = vtr(vb + (d * 4 + ks) * 1024), hh = vtr(vb + (d * 4 + ks) * 1024 + 512); o[d] = MFMA32(pa[ks], cat8(lo, hh), o[d]); }
        }
        if (kt + 1 < NT) DF_STORE(s ^ 1);
        __syncthreads();
    }
#undef DF_LOAD
#undef DF_STORE
    LAS float* ob = (LAS float*)lds;
    const float linv_own = 1.0f / l_run;
    const float wgt = (c == 1) ? -lam : 1.0f;
    if (c == 1) {
#pragma unroll
        for (int r = 0; r < 16; ++r) { const float f = __shfl(linv_own, crow(r, hi)) * wgt; const int row = 32 * wq + crow(r, hi);
#pragma unroll
            for (int d = 0; d < 4; ++d) ob[row * 132 + 32 * d + r32] = o[d][r] * f; }
    }
    __syncthreads();
    if (c == 0) {
#pragma unroll
        for (int r = 0; r < 16; ++r) { const float f = __shfl(linv_own, crow(r, hi)); const int row = 32 * wq + crow(r, hi);
#pragma unroll
            for (int d = 0; d < 4; ++d) ob[row * 132 + 32 * d + r32] += o[d][r] * f; }
    }
    __syncthreads();
    { const int row = tid >> 2, part = tid & 3; const LAS float* rp = ob + row * 132 + part * 32;
      f32x4 v[8]; float ss = 0.f;
#pragma unroll
      for (int j = 0; j < 8; ++j) { v[j] = *(const LAS f32x4*)(rp + 4 * j); ss += (v[j][0] * v[j][0] + v[j][1] * v[j][1]) + (v[j][2] * v[j][2] + v[j][3] * v[j][3]); }
      ss += __shfl_xor(ss, 1); ss += __shfl_xor(ss, 2);
      const float rn = oscale / sqrtf(ss * (1.0f / 128.0f) + 1e-5f);
      bf16_t* op = O + (rowbase + q0 + row) * 512 + h * 128 + part * 32;
#pragma unroll
      for (int j = 0; j < 4; ++j) { const f32x4 g0 = *(const f32x4*)(subg + part * 32 + 8 * j), g1 = *(const f32x4*)(subg + part * 32 + 8 * j + 4);
          const f32x4 a = v[2 * j] * g0 * rn, bb = v[2 * j + 1] * g1 * rn;
          u32x4 w; w.x = cvtpk(a[0], a[1]); w.y = cvtpk(a[2], a[3]); w.z = cvtpk(bb[0], bb[1]); w.w = cvtpk(bb[2], bb[3]);
          *(u32x4*)(op + 8 * j) = w; } }
    __syncthreads();
}

__device__ __forceinline__ void sb_unit(LAS unsigned char* lds, int b, int h, int qb, const bf16_t* __restrict__ Q, const bf16_t* __restrict__ K, const bf16_t* __restrict__ V, bf16_t* __restrict__ O) {
    int tid_ = threadIdx.x; asm volatile("" : "+v"(tid_));
    const int tid = tid_, lane = tid & 63, wid = __builtin_amdgcn_readfirstlane(tid >> 6), r32 = lane & 31, hi = lane >> 5;
    const size_t rowbase = (size_t)b * SEQ;
    const int q0 = qb * 256, qw0 = q0 + 32 * wid, kt_hi = (q0 + 256) / 64 - 1;
    const bf16_t* kg = K + (rowbase + lane) * 512 + h * 64 + wid * 8;
    const bf16_t* vg = V + (rowbase + 16 * (wid & 3) + (lane >> 2)) * 512 + h * 64 + (wid >> 2) * 32 + (lane & 3) * 8;
    LAS unsigned* flags = (LAS unsigned*)(lds + 32768);
    LAS unsigned char* ost = lds + 36864 + wid * 4608;
    u32x4 rk, rv;
#define SB_LOAD(t) do { const size_t off_ = (size_t)(t) * 64 * 512; rk = *(const u32x4*)(kg + off_); rv = *(const u32x4*)(vg + off_); } while (0)
#define SB_STORE(s) do { LAS unsigned char* sb_ = lds + (s) * 16384 + wid * 1024 + lane * 16; *(LAS u32x4*)(sb_) = rk; *(LAS u32x4*)(sb_ + 8192) = rv; } while (0)
    bf16x8 qr[4];
    { const bf16_t* qp = Q + (rowbase + qw0 + r32) * 512 + h * 64 + hi * 8;
#pragma unroll
      for (int d0 = 0; d0 < 4; ++d0) qr[d0] = *(const bf16x8*)(qp + d0 * 16); }
    float carry = 0.f; bool done = false;
    f32x16 o[2]; o[0] = (f32x16){}; o[1] = (f32x16){};
    SB_LOAD(kt_hi); SB_STORE(0); __syncthreads();
    int it = 0;
    for (int kt = kt_hi; kt >= 0; --kt, ++it) {
        const int s = it & 1;
        if (kt > 0) SB_LOAD(kt - 1);
        if (!done && 64 * kt < qw0 + 31) {
            LAS const unsigned char* kb = lds + s * 16384 + hi * 1024 + r32 * 16;
            f32x16 p0 = (f32x16){}, p1 = (f32x16){};
#pragma unroll
            for (int d0 = 0; d0 < 4; ++d0) { const bf16x8 a0 = *(LAS const bf16x8*)(kb + d0 * 2048), a1 = *(LAS const bf16x8*)(kb + d0 * 2048 + 512);
                p0 = MFMA32(a0, qr[d0], p0); p1 = MFMA32(a1, qr[d0], p1); }
            const int q = qw0 + r32, kb0 = 64 * kt + 4 * hi;
            f32x16 L0, L1;
#pragma unroll
            for (int r = 0; r < 16; ++r) { const int key = kb0 + (r & 3) + 8 * (r >> 2);
                { const float z = p0[r], sp = fmaxf(z, 0.f) + __logf(1.0f + __expf(-fabsf(z))); const bool v = key < q; L0[r] = v ? -sp : 0.f; p0[r] = v ? (z - sp) : -1e30f; }
                { const float z = p1[r], sp = fmaxf(z, 0.f) + __logf(1.0f + __expf(-fabsf(z))); const bool v = (key + 32) < q; L1[r] = v ? -sp : 0.f; p1[r] = v ? (z - sp) : -1e30f; } }
            float own[8], par[8], S[8];
#pragma unroll
            for (int j = 0; j < 4; ++j) { own[j] = (L0[4 * j] + L0[4 * j + 1]) + (L0[4 * j + 2] + L0[4 * j + 3]); own[4 + j] = (L1[4 * j] + L1[4 * j + 1]) + (L1[4 * j + 2] + L1[4 * j + 3]); }
#pragma unroll
            for (int j = 0; j < 8; ++j) par[j] = __shfl_xor(own[j], 32);
            S[7] = 0.f;
#pragma unroll
            for (int j = 6; j >= 0; --j) S[j] = S[j + 1] + (own[j + 1] + par[j + 1]);
            const float total = S[0] + (own[0] + par[0]);
#pragma unroll
            for (int j = 0; j < 8; ++j) { const float lg = carry + S[j] + (hi == 0 ? par[j] : 0.f);
                if (j < 4) { const int rb = 4 * j; const float l3 = lg, l2 = l3 + L0[rb + 3], l1 = l2 + L0[rb + 2], l0 = l1 + L0[rb + 1];
                    p0[rb] = __expf(p0[rb] + l0); p0[rb + 1] = __expf(p0[rb + 1] + l1); p0[rb + 2] = __expf(p0[rb + 2] + l2); p0[rb + 3] = __expf(p0[rb + 3] + l3); }
                else { const int rb = 4 * (j - 4); const float l3 = lg, l2 = l3 + L1[rb + 3], l1 = l2 + L1[rb + 2], l0 = l1 + L1[rb + 1];
                    p1[rb] = __expf(p1[rb] + l0); p1[rb + 1] = __expf(p1[rb + 1] + l1); p1[rb + 2] = __expf(p1[rb + 2] + l2); p1[rb + 3] = __expf(p1[rb + 3] + l3); } }
            carry += total;
            bf16x8 pa[4]; pa[0] = packp(p0, 0); pa[1] = packp(p0, 1); pa[2] = packp(p1, 0); pa[3] = packp(p1, 1);
            LAS const unsigned char* vb = lds + s * 16384 + 8192 + ((lane >> 4) & 1) * 32 + (lane & 3) * 8 + (4 * hi + ((lane & 15) >> 2)) * 64;
#pragma unroll
            for (int d = 0; d < 2; ++d)
#pragma unroll
                for (int ks = 0; ks < 4; ++ks) { const s16x4 lo = vtr(vb + (d * 4 + ks) * 1024), hh = vtr(vb + (d * 4 + ks) * 1024 + 512); o[d] = MFMA32(pa[ks], cat8(lo, hh), o[d]); }
            done = __all(carry < -104.0f) != 0;
        }
        if (lane == 0) flags[s * 8 + wid] = done ? 1u : 0u;
        if (kt > 0) SB_STORE(s ^ 1);
        __syncthreads();
        unsigned all = 1u;
#pragma unroll
        for (int w = 0; w < 8; ++w) all &= flags[s * 8 + w];
        if (all) break;
    }
#undef SB_LOAD
#undef SB_STORE
#pragma unroll
    for (int d = 0; d < 2; ++d)
#pragma unroll
        for (int r = 0; r < 16; r += 2) { const unsigned w = cvtpk(o[d][r], o[d][r + 1]);
            *(LAS unsigned short*)(ost + crow(r, hi) * 144 + (32 * d + r32) * 2) = (unsigned short)(w & 0xffffu);
            *(LAS unsigned short*)(ost + crow(r + 1, hi) * 144 + (32 * d + r32) * 2) = (unsigned short)(w >> 16); }
    asm volatile("s_waitcnt lgkmcnt(0)" ::: "memory");
#pragma unroll
    for (int j = 0; j < 4; ++j) { const int idx = lane + 64 * j, row = idx >> 3, ch = idx & 7;
        const u32x4 w = *(LAS const u32x4*)(ost + row * 144 + ch * 16);
        *(u32x4*)(O + (rowbase + qw0 + row) * 512 + h * 64 + ch * 8) = w; }
    __syncthreads();
}
}

__device__ __forceinline__ int dest_row(int mode, int c) {
    if (mode == 1) { return (c < DFF) ? (256 * (c >> 7) + (c & 127)) : (256 * ((c - DFF) >> 7) + 128 + ((c - DFF) & 127)); }
    if (mode == 2) { if (c >= 1536 && c < 2560) { const int j = c & 63, half = j >> 5, q = (j & 31) >> 2, e = j & 3; return (c & ~63) + 8 * q + 4 * half + e; } return c; }
    return c;
}
__device__ __forceinline__ void transpose_item(const float* __restrict__ W, int K, int N, bf16_t* __restrict__ WT, int mode, LAS float* scr, int item, int lane) {
    const int nblk = N / 32, kb = item / nblk, nb = item % nblk, k0 = 64 * kb, n0 = 32 * nb;
#pragma unroll 8
    for (int i = 0; i < 32; ++i) { const int kk = 2 * i + (lane >> 5); scr[kk * 33 + (lane & 31)] = W[(size_t)(k0 + kk) * N + n0 + (lane & 31)]; }
    asm volatile("s_waitcnt lgkmcnt(0)" ::: "memory");
    const int c = lane & 7;
#pragma unroll
    for (int j = 0; j < 4; ++j) { const int n = (lane >> 3) + 8 * j; const LAS float* s = scr + (8 * c) * 33 + n;
        u32x4 o; o.x = cvtpk(s[0 * 33], s[1 * 33]); o.y = cvtpk(s[2 * 33], s[3 * 33]); o.z = cvtpk(s[4 * 33], s[5 * 33]); o.w = cvtpk(s[6 * 33], s[7 * 33]);
        *(u32x4*)(WT + (size_t)dest_row(mode, n0 + n) * K + k0 + 8 * c) = o; }
    asm volatile("s_waitcnt lgkmcnt(0)" ::: "memory");
}

template <bool HAS_F, bool WRITE_H, bool WRITE_U>
__device__ __forceinline__ void row_pass(const float* __restrict__ hin, float* __restrict__ hout, const bf16_t* __restrict__ F, float coef, const float* __restrict__ gpost, const float* __restrict__ gpre,
                                         bf16_t* __restrict__ U, int gw, int NGW, int lane_in) {
    int lane = lane_in; asm volatile("" : "+v"(lane));
    f32x4 gp[4], gq[4];
#pragma unroll
    for (int j = 0; j < 4; ++j) { gp[j] = HAS_F ? *(const f32x4*)(gpost + 256 * j + 4 * lane) : (f32x4){0.f, 0.f, 0.f, 0.f}; gq[j] = WRITE_U ? *(const f32x4*)(gpre + 256 * j + 4 * lane) : (f32x4){0.f, 0.f, 0.f, 0.f}; }
    for (int m = gw; m < M; m += NGW) {
        f32x4 hv[4];
#pragma unroll
        for (int j = 0; j < 4; ++j) hv[j] = *(const f32x4*)(hin + (size_t)m * DM + 256 * j + 4 * lane);
        if (HAS_F) {
            f32x4 fv[4]; float ss = 0.f;
#pragma unroll
            for (int j = 0; j < 4; ++j) { const u32x2 w = *(const u32x2*)(F + (size_t)m * DM + 256 * j + 4 * lane); fv[j] = (f32x4){bflo(w.x), bfhi(w.x), bflo(w.y), bfhi(w.y)};
                ss += (fv[j][0] * fv[j][0] + fv[j][1] * fv[j][1]) + (fv[j][2] * fv[j][2] + fv[j][3] * fv[j][3]); }
            const float r = coef / sqrtf(wave_sum(ss) * (1.0f / DM) + 1e-6f);
#pragma unroll
            for (int j = 0; j < 4; ++j) hv[j] = hv[j] + fv[j] * gp[j] * r;
        }
        if (WRITE_H) {
#pragma unroll
            for (int j = 0; j < 4; ++j) *(f32x4*)(hout + (size_t)m * DM + 256 * j + 4 * lane) = hv[j];
        }
        if (WRITE_U) {
            float s2 = 0.f;
#pragma unroll
            for (int j = 0; j < 4; ++j) s2 += (hv[j][0] * hv[j][0] + hv[j][1] * hv[j][1]) + (hv[j][2] * hv[j][2] + hv[j][3] * hv[j][3]);
            const float r2 = 1.0f / sqrtf(wave_sum(s2) * (1.0f / DM) + 1e-6f);
#pragma unroll
            for (int j = 0; j < 4; ++j) { const f32x4 uv = hv[j] * gq[j] * r2; u32x2 w; w.x = cvtpk(uv[0], uv[1]); w.y = cvtpk(uv[2], uv[3]); *(u32x2*)(U + (size_t)m * DM + 256 * j + 4 * lane) = w; }
        }
    }
}

#define XB_TMO      128
#define XB_XCNT(j)  (256  + 64 * (j))
#define XB_XSUB(j)  (1280 + 64 * (j))
#define XB_XGEN(j)  (2304 + 64 * (j))
#define XB_TOP      3328
#define XB_TOPGEN   3392
#define XCD_BAR_WORDS 3456
#define XB_SPIN_CAP (1u << 18)

__device__ __forceinline__ unsigned xb_ld(unsigned* p)              { return __hip_atomic_load(p, __ATOMIC_RELAXED, __HIP_MEMORY_SCOPE_AGENT); }
__device__ __forceinline__ unsigned xb_add(unsigned* p, unsigned v) { return __hip_atomic_fetch_add(p, v, __ATOMIC_RELAXED, __HIP_MEMORY_SCOPE_AGENT); }
__device__ __forceinline__ unsigned xb_xcc_id() { return (unsigned)__builtin_amdgcn_s_getreg((3 << 11) | 20) & 0xFu; }
#define XB_SPIN(cond, bar) do { unsigned _sp = 0; while (cond) { __builtin_amdgcn_s_sleep(1); \
    if ((++_sp & 255u) == 0u) { if (xb_ld(&(bar)[XB_TMO])) break; if (_sp > XB_SPIN_CAP) { atomicAdd(&(bar)[XB_TMO], 1u); break; } } } } while (0)

struct XcdBarrier {
    unsigned* bar; unsigned x;
    volatile LAS unsigned* st;
};

__device__ __forceinline__ XcdBarrier xcd_barrier_post(unsigned* bar, volatile LAS unsigned* st) {
    XcdBarrier b; b.bar = bar; b.x = xb_xcc_id(); b.st = st;
    if (threadIdx.x == 0) (void)xb_add(&bar[XB_XCNT(b.x)], 1u);
    return b;
}
__device__ __forceinline__ void xcd_barrier_complete(unsigned* bar, unsigned x, unsigned& nloc, unsigned& nx) {
    const unsigned G = gridDim.x * gridDim.y * gridDim.z;
    unsigned sum, cnt, mine, sp = 0u;
    for (;;) {
        sum = 0u; cnt = 0u; mine = 0u;
#pragma unroll
        for (unsigned j = 0; j < 16; ++j) { const unsigned c = xb_ld(&bar[XB_XCNT(j)]); sum += c; cnt += (c > 0u) ? 1u : 0u; mine = (j == x) ? c : mine; }
        if (sum == G) break;
        __builtin_amdgcn_s_sleep(1);
        if ((++sp & 255u) == 0u) { if (xb_ld(&bar[XB_TMO])) break; if (sp > XB_SPIN_CAP) { atomicAdd(&bar[XB_TMO], 1u); break; } }
    }
    nloc = mine > 0u ? mine : 1u; nx = cnt > 0u ? cnt : 1u;
}

__device__ __forceinline__ void xcd_barrier(const XcdBarrier& b) {
    asm volatile("s_waitcnt vmcnt(0)" ::: "memory");
    __syncthreads();
    if (threadIdx.x == 0) {
        unsigned* bar = b.bar;
        __builtin_amdgcn_s_waitcnt(0);
        unsigned nloc = b.st[0], nx = b.st[1];
        if (nloc == 0u) { xcd_barrier_complete(bar, b.x, nloc, nx); b.st[0] = nloc; b.st[1] = nx; }
        const unsigned old = xb_add(&bar[XB_XSUB(b.x)], 1u);
        const unsigned gen = old / nloc;
        if (old + 1u == (gen + 1u) * nloc) {
            __builtin_amdgcn_fence(__ATOMIC_RELEASE, "agent");
            asm volatile("s_waitcnt vmcnt(0)" ::: "memory");
            const unsigned og = xb_add(&bar[XB_TOP], 1u);
            const unsigned tg = og / nx;
            if (og + 1u == (tg + 1u) * nx) xb_add(&bar[XB_TOPGEN], 1u);
            else XB_SPIN(xb_ld(&bar[XB_TOPGEN]) == tg, bar);
            __builtin_amdgcn_fence(__ATOMIC_ACQUIRE, "agent");
            xb_add(&bar[XB_XGEN(b.x)], 1u);
            asm volatile("s_waitcnt vmcnt(0)" ::: "memory");
        } else {
            XB_SPIN(xb_ld(&bar[XB_XGEN(b.x)]) == gen, bar);
            __builtin_amdgcn_fence(__ATOMIC_ACQUIRE, "agent");
            asm volatile("s_waitcnt vmcnt(0)" ::: "memory");
        }
    }
    __syncthreads();
}


__global__ void __launch_bounds__(512, 2) fwd_megakernel(Args a) {
    extern __shared__ __attribute__((aligned(16))) unsigned char lds_raw[];
    LAS unsigned char* lds = (LAS unsigned char*)lds_raw;
    cg::grid_group grid = cg::this_grid();
    const int tid = threadIdx.x, lane = tid & 63, wave = __builtin_amdgcn_readfirstlane(tid >> 6);
    const int G = gridDim.x, bx = blockIdx.x, vcu = (G % 8 == 0) ? (bx % 8) * (G / 8) + bx / 8 : bx;
    const int gw = vcu * 8 + wave, NGW = G * 8;
    unsigned char* ws = a.ws;
    if (tid < 16) ((LAS unsigned*)(lds + LDS_MISC))[tid] = 0u;
    __syncthreads();
    XcdBarrier bar = xcd_barrier_post((unsigned*)(ws + WS_CTL), (volatile LAS unsigned*)(lds + LDS_MISC));
    const float* x = (const float*)a.in[0];
    const float* pin = (const float*)a.in[1];
    const int* positions = (const int*)a.in[2];
    float* hbuf = a.out;
    bf16_t* U = (bf16_t*)(ws + WS_U);
    bf16_t* F = (bf16_t*)(ws + WS_F);
    bf16_t* PB = (bf16_t*)(ws + WS_P);
    float* rope = (float*)(ws + WS_ROPE);
    bf16_t* R = (bf16_t*)(ws + WS_R);
    bf16_t* ACT = (bf16_t*)(ws + WS_R + R_ACT);
    float* TMP = (float*)(ws + WS_R + R_TMP);
    bf16_t* MRG = (bf16_t*)(ws + WS_R + R_MRG);
    bf16_t* GSB = (bf16_t*)(ws + WS_R + R_GSB);
    bf16_t* GDF = (bf16_t*)(ws + WS_R + R_GDF);
    bf16_t* OSB = (bf16_t*)(ws + WS_R + R_OSB);
    bf16_t* ODF = (bf16_t*)(ws + WS_R + R_ODF);

    if (PH & 1) {
        LAS float* scr = (LAS float*)(lds + wave * 16384);
        constexpr int I_GU = (DM / 64) * (2 * DFF / 32), I_D = (DFF / 64) * (DM / 32), I_IN = (DM / 64) * (DIN / 32), I_B = (512 / 64) * (DM / 32), I_O = (DM / 64) * (DM / 32), I_PP = (PLE / 64) * (DM / 32);
        constexpr int I_LAYER = 2 * I_GU + 2 * I_D + I_IN + 2 * I_B + 2 * I_O + I_PP;
        for (int it = gw; it < DEPTH * I_LAYER; it += NGW) {
            const int L = it / I_LAYER; int r = it % I_LAYER;
            bf16_t* wl = (bf16_t*)(ws + WS_W + (size_t)L * LAYER_W);
            if (r < I_GU) { transpose_item((const float*)a.in[4] + (size_t)L * DM * 2 * DFF, DM, 2 * DFF, wl + O_WGU1 / 2, 1, scr, r, lane); continue; } r -= I_GU;
            if (r < I_D) { transpose_item((const float*)a.in[5] + (size_t)L * DFF * DM, DFF, DM, wl + O_WD1 / 2, 0, scr, r, lane); continue; } r -= I_D;
            if (r < I_IN) { transpose_item((const float*)a.in[8] + (size_t)L * DM * DIN, DM, DIN, wl + O_WIN / 2, 2, scr, r, lane); continue; } r -= I_IN;
            if (r < I_B) { transpose_item((const float*)a.in[11] + (size_t)L * 512 * DM, 512, DM, wl + O_WBS / 2, 0, scr, r, lane); continue; } r -= I_B;
            if (r < I_B) { transpose_item((const float*)a.in[12] + (size_t)L * 512 * DM, 512, DM, wl + O_WBD / 2, 0, scr, r, lane); continue; } r -= I_B;
            if (r < I_O) { transpose_item((const float*)a.in[13] + (size_t)L * DM * DM, DM, DM, wl + O_WOUT / 2, 0, scr, r, lane); continue; } r -= I_O;
            if (r < I_GU) { transpose_item((const float*)a.in[16] + (size_t)L * DM * 2 * DFF, DM, 2 * DFF, wl + O_WGU2 / 2, 1, scr, r, lane); continue; } r -= I_GU;
            if (r < I_D) { transpose_item((const float*)a.in[17] + (size_t)L * DFF * DM, DFF, DM, wl + O_WD2 / 2, 0, scr, r, lane); continue; } r -= I_D;
            if (r < I_O) { transpose_item((const float*)a.in[20] + (size_t)L * DM * DM, DM, DM, wl + O_WPG / 2, 0, scr, r, lane); continue; } r -= I_O;
            transpose_item((const float*)a.in[21] + (size_t)L * PLE * DM, PLE, DM, wl + O_WPP / 2, 0, scr, r, lane);
        }
        { const size_t n4 = (size_t)DEPTH * M * PLE / 4; const size_t gt = (size_t)vcu * 512 + tid, NT_ = (size_t)G * 512;
          for (size_t i = gt; i < n4; i += NT_) { const f32x4 v = *(const f32x4*)(pin + 4 * i); u32x2 w; w.x = cvtpk(v[0], v[1]); w.y = cvtpk(v[2], v[3]); *(u32x2*)(PB + 4 * i) = w; } }
        { const int gt = vcu * 512 + tid, NT_ = G * 512;
          for (int i = gt; i < M * 32; i += NT_) { const int m = i >> 5, fi = i & 31; const float ang = __fmul_rn((float)positions[m], a.invf[fi]);
              const double rev = (double)ang * 0.15915494309189533577; const float fr = (float)(rev - rint(rev));
              rope[2 * i] = __builtin_amdgcn_cosf(fr); rope[2 * i + 1] = __builtin_amdgcn_sinf(fr); } }
        row_pass<false, false, true>(x, nullptr, nullptr, 0.f, nullptr, (const float*)a.in[3], U, gw, NGW, lane);
    }
    grid.sync();

    for (int L_ = 0; L_ < DEPTH; ++L_) {
        int L = L_; asm volatile("" : "+s"(L));
        const bf16_t* wl = (const bf16_t*)(ws + WS_W + (size_t)L * LAYER_W);
        const size_t go = (size_t)L * DM;
        if (PH & 2) { pg8::Gemm g{U, wl + O_WGU1 / 2, M, 2 * DFF, DM}; pg8::StaticOrder S; S.init(M, 2 * DFF, G, bx); pg8::EpiSwiglu E{ACT};
          pg8::gemm_phase<pg8::EpiSwiglu, pg8::StaticOrder, true, true>(lds, g, S, E); }
        GRID_SYNC();
        if (PH & 4) { pg8::Gemm g{ACT, wl + O_WD1 / 2, M, DM, DFF}; pg8::StaticOrder S; S.init(M, DM, G, bx); pg8::EpiPlain E{F, DM};
          pg8::gemm_phase<pg8::EpiPlain, pg8::StaticOrder, true, true>(lds, g, S, E); }
        GRID_SYNC();
        if (PH & 8) row_pass<true, true, true>(L == 0 ? x : hbuf, hbuf, F, 0.5f, (const float*)a.in[6] + go, (const float*)a.in[7] + go, U, gw, NGW, lane);
        GRID_SYNC();
        if (PH & 16) { pg8::Gemm g{U, wl + O_WIN / 2, M, DIN, DM}; pg8::StaticOrder S; S.init(M, DIN, G, bx); pg8::EpiWin E{R, rope};
          pg8::gemm_phase<pg8::EpiWin, pg8::StaticOrder, true, true>(lds, g, S, E); }
        GRID_SYNC();
        {
            const float* lp = (const float*)a.in[9] + (size_t)L * 256;
            const float s1 = wave_sum(lp[lane] * lp[64 + lane]), s2 = wave_sum(lp[128 + lane] * lp[192 + lane]);
            const float lam_init = a.lam_init[L], lam = expf(s1) - expf(s2) + lam_init;
            const float* subg = (const float*)a.in[10] + (size_t)L * 128;
            const bf16_t* SBQ = R + (R_SBQ / 2); const bf16_t* SBK = R + (R_SBK / 2); const bf16_t* SBV = R + (R_SBV / 2);
            const bf16_t* DFQ = R + (R_DFQ / 2); const bf16_t* DFK = R + (R_DFK / 2); const bf16_t* DFV = R + (R_DFV / 2);
            for (int rep_ = 0; rep_ < ATT_REP; ++rep_) {
            if (PH & 32) for (int un = vcu; un < 256; un += G) { const int bh = un >> 4, sidx = un & 15;
                att::df_unit(lds, bh >> 2, bh & 3, 31 - sidx, DFQ, DFK, DFV, ODF, lam, 1.0f - lam_init, subg);
                att::df_unit(lds, bh >> 2, bh & 3, sidx, DFQ, DFK, DFV, ODF, lam, 1.0f - lam_init, subg); }
            if (PH & 64) for (int un = vcu; un < 512; un += G) { const int bh = un >> 4, qb = un & 15;
                att::sb_unit(lds, bh >> 3, bh & 7, qb, SBQ, SBK, SBV, OSB); }
            }
        }
        GRID_SYNC();
        if (PH & 128) { pg8::Gemm g{OSB, wl + O_WBS / 2, M, DM, 512}; pg8::StaticOrder S; S.init(M, DM, G, bx); pg8::EpiTwo<0> E{TMP, GSB, nullptr};
          pg8::gemm_phase<pg8::EpiTwo<0>, pg8::StaticOrder, true, true>(lds, g, S, E); }
        if (PH & 128) { pg8::Gemm g{ODF, wl + O_WBD / 2, M, DM, 512}; pg8::StaticOrder S; S.init(M, DM, G, bx); pg8::EpiTwo<1> E{TMP, GDF, MRG};
          pg8::gemm_phase<pg8::EpiTwo<1>, pg8::StaticOrder, true, true>(lds, g, S, E); }
        GRID_SYNC();
        if (PH & 4) { pg8::Gemm g{MRG, wl + O_WOUT / 2, M, DM, DM}; pg8::StaticOrder S; S.init(M, DM, G, bx); pg8::EpiPlain E{F, DM};
          pg8::gemm_phase<pg8::EpiPlain, pg8::StaticOrder, true, true>(lds, g, S, E); }
        GRID_SYNC();
        row_pass<true, true, true>(hbuf, hbuf, F, 1.0f, (const float*)a.in[14] + go, (const float*)a.in[15] + go, U, gw, NGW, lane);
        GRID_SYNC();
        if (PH & 2) { pg8::Gemm g{U, wl + O_WGU2 / 2, M, 2 * DFF, DM}; pg8::StaticOrder S; S.init(M, 2 * DFF, G, bx); pg8::EpiSwiglu E{ACT};
          pg8::gemm_phase<pg8::EpiSwiglu, pg8::StaticOrder, true, true>(lds, g, S, E); }
        GRID_SYNC();
        if (PH & 4) { pg8::Gemm g{ACT, wl + O_WD2 / 2, M, DM, DFF}; pg8::StaticOrder S; S.init(M, DM, G, bx); pg8::EpiPlain E{F, DM};
          pg8::gemm_phase<pg8::EpiPlain, pg8::StaticOrder, true, true>(lds, g, S, E); }
        GRID_SYNC();
        row_pass<true, true, true>(hbuf, hbuf, F, 0.5f, (const float*)a.in[18] + go, (const float*)a.in[19] + go, U, gw, NGW, lane);
        GRID_SYNC();
        if (PH & 256) { pg8::Gemm g{U, wl + O_WPG / 2, M, DM, DM}; pg8::StaticOrder S; S.init(M, DM, G, bx); pg8::EpiTwo<2> E{TMP, nullptr, nullptr};
          pg8::gemm_phase<pg8::EpiTwo<2>, pg8::StaticOrder, true, true>(lds, g, S, E); }
        if (PH & 256) { pg8::Gemm g{PB + (size_t)L * M * PLE, wl + O_WPP / 2, M, DM, PLE}; pg8::StaticOrder S; S.init(M, DM, G, bx); pg8::EpiTwo<3> E{TMP, nullptr, F};
          pg8::gemm_phase<pg8::EpiTwo<3>, pg8::StaticOrder, true, true>(lds, g, S, E); }
        GRID_SYNC();
        if (L + 1 < DEPTH) row_pass<true, true, true>(hbuf, hbuf, F, 1.0f, (const float*)a.in[22] + go, (const float*)a.in[3] + go + DM, U, gw, NGW, lane);
        else row_pass<true, true, false>(hbuf, hbuf, F, 1.0f, (const float*)a.in[22] + go, nullptr, nullptr, gw, NGW, lane);
        if (L + 1 < DEPTH) GRID_SYNC();
    }
}

extern "C" void kernel_launch(void* const* d_in, const int* in_sizes, int n_in, void* d_out, int out_size, void* d_ws, size_t ws_size, hipStream_t stream) {
    static int grid_blocks = 0;
    if (grid_blocks == 0) {
        if (n_in != 23 || out_size != M * DM || ws_size < WS_END) { fprintf(stderr, "kernel_launch: unexpected shapes (n_in %d out %d ws %zu)\n", n_in, out_size, ws_size); grid_blocks = -1; return; }
        int dev = 0, cus = 0, per_cu = 0;
        hipGetDevice(&dev);
        hipDeviceGetAttribute(&cus, hipDeviceAttributeMultiprocessorCount, dev);
        if (hipFuncSetAttribute((const void*)fwd_megakernel, hipFuncAttributeMaxDynamicSharedMemorySize, LDS_BYTES) != hipSuccess) { fprintf(stderr, "kernel_launch: hipFuncSetAttribute failed\n"); grid_blocks = -1; return; }
        if (hipOccupancyMaxActiveBlocksPerMultiprocessor(&per_cu, (const void*)fwd_megakernel, 512, LDS_BYTES) != hipSuccess || per_cu < 1) { fprintf(stderr, "kernel_launch: occupancy query failed (%d)\n", per_cu); per_cu = 1; }
        (void)hipGetLastError();
        grid_blocks = cus * per_cu;
    }
    if (grid_blocks < 0) return;
    Args a{};
    for (int i = 0; i < 23; ++i) a.in[i] = d_in[i];
    a.out = (float*)d_out; a.ws = (unsigned char*)d_ws;
    for (int i = 0; i < 32; ++i) a.invf[i] = powf(10000.0f, -(float)i / 32.0f);
    for (int i = 0; i < 4; ++i) a.lam_init[i] = (float)(0.8 - 0.6 * exp(-0.3 * (double)i));
    if (hipMemsetAsync((unsigned char*)d_ws + WS_CTL, 0, CTL_BYTES, stream) != hipSuccess) { fprintf(stderr, "kernel_launch: memset failed\n"); return; }
    void* args[] = {&a};
    hipError_t e = hipLaunchCooperativeKernel((const void*)fwd_megakernel, dim3(grid_blocks), dim3(512), args, LDS_BYTES, stream);
    if (e != hipSuccess) fprintf(stderr, "cooperative launch failed: %s (grid %d)\n", hipGetErrorString(e), grid_blocks);
}
```

```cpp
#include <hip/hip_runtime.h>
#include <hip/hip_cooperative_groups.h>
#include <cstdio>
#include <cstdint>
#include <cmath>
namespace cg = cooperative_groups;
namespace pg8 {
#define PG8_LAS __attribute__((address_space(3)))
typedef unsigned short bf16_t;
typedef short bf16x8 __attribute__((ext_vector_type(8)));
typedef float f32x4 __attribute__((ext_vector_type(4)));
typedef unsigned u32x4 __attribute__((ext_vector_type(4)));
constexpr int BM = 256, BK = 64, HALF = 128, HTB = HALF * BK * 2  , STAGE_BYTES = 8 * HTB, NXCD = 8, WGM = 8;

__host__ __device__ __forceinline__ int lds_byte(int r, int c) { const int st = (r >> 4) * 2 + (c >> 5), rr = r & 15, cc = c & 31, ob = rr * 64 + cc * 2; return st * 1024 + (ob ^ (((ob >> 9) & 1) << 5)); }
__host__ __device__ __forceinline__ void stage_rc(int b, int& R, int& C) { const int st = b / 1024, sb = b % 1024, swz = sb ^ (((sb >> 9) & 1) << 5); R = (st >> 1) * 16 + swz / 64; C = (st & 1) * 32 + (swz % 64) / 2; }
__host__ __device__ __forceinline__ int perm32(int rho) { const int n = rho >> 4, i = rho & 15; return 8 * (i >> 2) + 4 * n + (i & 3); }

struct Unit { int pm, pn; };
struct Gemm { const bf16_t* A; const bf16_t* Bt; int M, N, K; };

struct StaticOrder {
    int nM, nN, nwg, G, c;
    __host__ __device__ void init(int M, int N, int G_, int c_) { nM = M / BM; nN = N / BM; nwg = nM * nN; G = G_; c = c_; }
    __host__ __device__ bool next(int i, Unit& u) const {
        const long L = (long)i * G + c; if (L >= nwg) return false;
        int wgid = (int)L; { const int q = nwg / NXCD, r = nwg % NXCD, xcd = wgid % NXCD, off = wgid / NXCD; wgid = (xcd < r ? xcd * (q + 1) : r * (q + 1) + (xcd - r) * q) + off; }
        const int nig = WGM * nN, gid = wgid / nig, fm = gid * WGM, gsz = (nM - fm) < WGM ? (nM - fm) : WGM;
        u.pm = fm + ((wgid % nig) % gsz); u.pn = (wgid % nig) / gsz; return true;
    }
    __device__ __forceinline__ void a_ready(const Unit&) const {}
    __device__ __forceinline__ void done(const Unit&) const {}
};

}
namespace pg8 {
template <class Epi, class Sched, bool ALIGN_EPI = false, bool SP2 = false>
__device__ __forceinline__ void gemm_phase(PG8_LAS unsigned char* lds, const Gemm g, const Sched& S, const Epi& E) {
    int tid_ = threadIdx.x; asm volatile("" : "+v"(tid_));
    const int tid = tid_, wid = __builtin_amdgcn_readfirstlane(tid >> 6), lane = tid & 63, wr = wid >> 2, wc = wid & 3, fr = lane & 15, fq = lane >> 4;
    const int K = g.K, nt = K / BK;
    unsigned voffA[2], voffB[2];
#pragma unroll
    for (int i = 0; i < 2; ++i) { int R, C; stage_rc(tid * 16 + i * 8192, R, C); const int Rb = Epi::PERM ? ((R & ~31) + perm32(R & 31)) : R;
        voffA[i] = (unsigned)(R * K + C) * 2u; voffB[i] = (unsigned)(Rb * K + C) * 2u; }
    const size_t kstep = (size_t)(BK * 2);
    const size_t hstep = (size_t)HALF * K * 2;
    const size_t tstep = 2 * hstep;
    const unsigned ldsw = (unsigned)wid * 1024u;
    const int aoff = lds_byte(wr * 64 + fr, fq * 8), boff = lds_byte(wc * 32 + fr, fq * 8);
#define PG8_SA(b, h) (((b) * 2 + (h)) * HTB)
#define PG8_SB(b, h) ((4 + (b) * 2 + (h)) * HTB)
#define PG8_STAGE(bufoff, gbase, voff) do { _Pragma("unroll") for (int _i = 0; _i < 2; ++_i) \
        __builtin_amdgcn_global_load_lds((const unsigned*)((const char*)(gbase) + (voff)[_i]), (PG8_LAS unsigned*)(lds + (bufoff) + ldsw + _i * 8192), 16, 0, 0); } while (0)
#define PG8_LDA(dst, b, h) do { _Pragma("unroll") for (int m = 0; m < 4; ++m) _Pragma("unroll") for (int k = 0; k < 2; ++k) dst[m][k] = *(const PG8_LAS bf16x8*)(lds + PG8_SA(b, h) + aoff + m * 2048 + k * 1024); } while (0)
#define PG8_LDB(dst, b, h) do { _Pragma("unroll") for (int n = 0; n < 2; ++n) _Pragma("unroll") for (int k = 0; k < 2; ++k) dst[n][k] = *(const PG8_LAS bf16x8*)(lds + PG8_SB(b, h) + boff + n * 2048 + k * 1024); } while (0)
#define PG8_MMA(ai, bj, At, Bt) do { __builtin_amdgcn_s_setprio(1); _Pragma("unroll") for (int m = 0; m < 4; ++m) _Pragma("unroll") for (int n = 0; n < 2; ++n) _Pragma("unroll") for (int k = 0; k < 2; ++k) \
        acc[ai][bj][m][n] = __builtin_amdgcn_mfma_f32_16x16x32_bf16(Bt[n][k], At[m][k], acc[ai][bj][m][n], 0, 0, 0); __builtin_amdgcn_s_setprio(0); } while (0)
#define PG8_WAIT_V(n) asm volatile("s_waitcnt vmcnt(" #n ")" ::: "memory")
#define PG8_WAIT_L(n) asm volatile("s_waitcnt lgkmcnt(" #n ")" ::: "memory")
#define PG8_BAR __builtin_amdgcn_s_barrier()
#define PG8_SCHED __builtin_amdgcn_sched_barrier(0)
    Unit cur, nxt; int ui = 0;
    if (!S.next(0, cur)) return;
    f32x4 acc[2][2][4][2];
#pragma unroll
    for (int a = 0; a < 2; ++a)
#pragma unroll
        for (int b = 0; b < 2; ++b)
#pragma unroll
            for (int m = 0; m < 4; ++m)
#pragma unroll
                for (int n = 0; n < 2; ++n) acc[a][b][m][n] = (f32x4){0.f, 0.f, 0.f, 0.f};
    bf16x8 At[4][2], B0[2][2], B1[2][2];
    const char* cA = (const char*)g.A + (size_t)cur.pm * tstep; const char* cB = (const char*)g.Bt + (size_t)cur.pn * tstep;
    S.a_ready(cur);
    if constexpr (SP2) {
        PG8_STAGE(PG8_SB(0, 0), cB, voffB); PG8_STAGE(PG8_SB(0, 1), cB + hstep, voffB); PG8_STAGE(PG8_SA(0, 0), cA, voffA); PG8_STAGE(PG8_SA(0, 1), cA + hstep, voffA);
        if (wr == 1) PG8_BAR;
        PG8_WAIT_V(2); PG8_BAR;
        PG8_STAGE(PG8_SB(1, 0), cB + kstep, voffB); PG8_STAGE(PG8_SA(1, 0), cA + kstep, voffA); PG8_STAGE(PG8_SB(1, 1), cB + hstep + kstep, voffB);
        PG8_WAIT_V(6); PG8_BAR;
    } else {
        PG8_STAGE(PG8_SB(0, 0), cB, voffB); PG8_STAGE(PG8_SA(0, 0), cA, voffA); PG8_STAGE(PG8_SB(0, 1), cB + hstep, voffB); PG8_STAGE(PG8_SA(0, 1), cA + hstep, voffA);
        if (wr == 1) PG8_BAR;
        PG8_WAIT_V(4); PG8_BAR;
        PG8_STAGE(PG8_SB(1, 0), cB + kstep, voffB); PG8_STAGE(PG8_SA(1, 0), cA + kstep, voffA); PG8_STAGE(PG8_SB(1, 1), cB + hstep + kstep, voffB);
        PG8_WAIT_V(6); PG8_BAR;
    }
    for (;;) {
        const bool has_next = S.next(ui + 1, nxt);
        const char* nA = has_next ? (const char*)g.A + (size_t)nxt.pm * tstep : cA; const char* nB = has_next ? (const char*)g.Bt + (size_t)nxt.pn * tstep : cB;
#pragma unroll 1
        for (int t = 0; t < nt; t += 2) {
            const bool last = (t == nt - 2);
            const char* a1 = cA + (size_t)(t + 1) * kstep;
            const char* a2 = last ? nA : cA + (size_t)(t + 2) * kstep; const char* b2 = last ? nB : cB + (size_t)(t + 2) * kstep;
            const char* a3 = a2 + kstep; const char* b3 = b2 + kstep;
            if (last && has_next) S.a_ready(nxt);
            if constexpr (SP2) {
            PG8_LDB(B0, 0, 0); PG8_LDB(B1, 0, 1); PG8_SCHED; PG8_LDA(At, 0, 0); PG8_STAGE(PG8_SA(1, 1), a1 + hstep, voffA);
            PG8_WAIT_V(8); PG8_WAIT_L(0); PG8_BAR; PG8_MMA(0, 0, At, B0); PG8_MMA(0, 1, At, B1); PG8_BAR; PG8_SCHED;
            PG8_LDA(At, 0, 1); PG8_STAGE(PG8_SB(0, 0), b2, voffB); PG8_STAGE(PG8_SB(0, 1), b2 + hstep, voffB); PG8_STAGE(PG8_SA(0, 0), a2, voffA);
            PG8_WAIT_V(8); PG8_WAIT_L(0); PG8_BAR; PG8_MMA(1, 0, At, B0); PG8_MMA(1, 1, At, B1); PG8_BAR; PG8_SCHED;
            PG8_LDB(B0, 1, 0); PG8_LDB(B1, 1, 1); PG8_SCHED; PG8_LDA(At, 1, 0); PG8_STAGE(PG8_SA(0, 1), a2 + hstep, voffA);
            PG8_WAIT_V(8); PG8_WAIT_L(0); PG8_BAR; PG8_MMA(0, 0, At, B0); PG8_MMA(0, 1, At, B1); PG8_BAR; PG8_SCHED;
            PG8_LDA(At, 1, 1); PG8_STAGE(PG8_SB(1, 0), b3, voffB); PG8_STAGE(PG8_SB(1, 1), b3 + hstep, voffB); PG8_STAGE(PG8_SA(1, 0), a3, voffA);
            PG8_WAIT_V(8); PG8_WAIT_L(0); PG8_BAR; PG8_MMA(1, 0, At, B0); PG8_MMA(1, 1, At, B1); PG8_BAR; PG8_SCHED;
            } else {
            PG8_LDB(B0, 0, 0); PG8_SCHED; PG8_LDA(At, 0, 0); PG8_STAGE(PG8_SA(1, 1), a1 + hstep, voffA);
            PG8_WAIT_L(8); PG8_BAR; PG8_WAIT_L(0); PG8_MMA(0, 0, At, B0); PG8_BAR; PG8_SCHED;
            PG8_LDB(B1, 0, 1); PG8_STAGE(PG8_SB(0, 0), b2, voffB);
            PG8_BAR; PG8_WAIT_L(0); PG8_MMA(0, 1, At, B1); PG8_BAR;
            PG8_LDA(At, 0, 1); PG8_STAGE(PG8_SA(0, 0), a2, voffA);
            PG8_BAR; PG8_WAIT_L(0); PG8_MMA(1, 0, At, B0); PG8_BAR; PG8_SCHED;
            PG8_STAGE(PG8_SB(0, 1), b2 + hstep, voffB);
            PG8_WAIT_V(6); PG8_BAR; PG8_MMA(1, 1, At, B1); PG8_BAR;
            PG8_LDB(B0, 1, 0); PG8_SCHED; PG8_LDA(At, 1, 0); PG8_STAGE(PG8_SA(0, 1), a2 + hstep, voffA);
            PG8_WAIT_L(8); PG8_BAR; PG8_WAIT_L(0); PG8_MMA(0, 0, At, B0); PG8_BAR; PG8_SCHED;
            PG8_LDB(B1, 1, 1); PG8_STAGE(PG8_SB(1, 0), b3, voffB);
            PG8_BAR; PG8_WAIT_L(0); PG8_MMA(0, 1, At, B1); PG8_BAR;
            PG8_LDA(At, 1, 1); PG8_STAGE(PG8_SA(1, 0), a3, voffA);
            PG8_BAR; PG8_WAIT_L(0); PG8_MMA(1, 0, At, B0); PG8_BAR; PG8_SCHED;
            PG8_STAGE(PG8_SB(1, 1), b3 + hstep, voffB);
            PG8_WAIT_V(6); PG8_BAR; PG8_MMA(1, 1, At, B1); PG8_BAR;
            }
        }
        if constexpr (ALIGN_EPI) { if (wr == 0) PG8_BAR; }
        if constexpr (!Epi::AFTER_DRAIN) { E(acc, cur, wr, wc, fr, fq); S.done(cur); }
        if (!has_next) break;
#pragma unroll
        for (int a = 0; a < 2; ++a)
#pragma unroll
            for (int b = 0; b < 2; ++b)
#pragma unroll
                for (int m = 0; m < 4; ++m)
#pragma unroll
                    for (int n = 0; n < 2; ++n) acc[a][b][m][n] = (f32x4){0.f, 0.f, 0.f, 0.f};
        cur = nxt; cA = nA; cB = nB; ++ui;
        if constexpr (ALIGN_EPI) { if (wr == 1) PG8_BAR; }
    }
    PG8_WAIT_V(0);
    if constexpr (!ALIGN_EPI) { if (wr == 0) PG8_BAR; }
    PG8_BAR;
    if constexpr (Epi::AFTER_DRAIN) { E.fused(acc, cur, wr, wc, fr, fq, lds, wid, lane); S.done(cur); }
#undef PG8_SA
#undef PG8_SB
#undef PG8_STAGE
#undef PG8_LDA
#undef PG8_LDB
#undef PG8_MMA
#undef PG8_WAIT_V
#undef PG8_WAIT_L
#undef PG8_BAR
#undef PG8_SCHED
}
}
#define LAS __attribute__((address_space(3)))
typedef unsigned short bf16_t;
typedef short bf16x8 __attribute__((ext_vector_type(8)));
typedef short s16x4 __attribute__((ext_vector_type(4)));
typedef float f32x4 __attribute__((ext_vector_type(4)));
typedef float f32x16 __attribute__((ext_vector_type(16)));
typedef unsigned u32x4 __attribute__((ext_vector_type(4)));
typedef unsigned u32x2 __attribute__((ext_vector_type(2)));

constexpr int NB = 4, SEQ = 4096, DM = 1024, DFF = 2816, DIN = 5120, DEPTH = 4, PLE = 256;
constexpr int M = NB * SEQ;
constexpr size_t MiB = 1u << 20;
constexpr size_t SZ_WGU = (size_t)2 * DFF * DM * 2, SZ_WD = (size_t)DM * DFF * 2, SZ_WIN = (size_t)DIN * DM * 2, SZ_WB = (size_t)DM * 512 * 2, SZ_WO = (size_t)DM * DM * 2, SZ_WPP = (size_t)DM * PLE * 2;
constexpr size_t O_WGU1 = 0, O_WD1 = O_WGU1 + SZ_WGU, O_WIN = O_WD1 + SZ_WD, O_WBS = O_WIN + SZ_WIN, O_WBD = O_WBS + SZ_WB, O_WOUT = O_WBD + SZ_WB, O_WGU2 = O_WOUT + SZ_WO,
                 O_WD2 = O_WGU2 + SZ_WGU, O_WPG = O_WD2 + SZ_WD, O_WPP = O_WPG + SZ_WO, LAYER_W = O_WPP + SZ_WPP;
constexpr size_t WS_CTL = 198 * MiB, CTL_BYTES = 16384; constexpr int XCD_BAR_WORDS_C = 3456;
constexpr size_t WS_W = 0, WS_U = 200 * MiB, WS_F = 232 * MiB, WS_P = 264 * MiB, WS_ROPE = 296 * MiB, WS_R = 300 * MiB, WS_END = 492 * MiB;
static_assert(LAYER_W * DEPTH <= WS_CTL && XCD_BAR_WORDS_C * 4 <= CTL_BYTES, "weights fit");
constexpr int LDS_MISC = 131072;
constexpr size_t R_SBQ = 0, R_SBK = 16 * MiB, R_SBV = 32 * MiB, R_DFQ = 48 * MiB, R_DFK = 64 * MiB, R_DFV = 80 * MiB, R_GSB = 96 * MiB, R_GDF = 128 * MiB, R_OSB = 160 * MiB, R_ODF = 176 * MiB;
constexpr size_t R_TMP = 0, R_MRG = 64 * MiB, R_ACT = 0;
constexpr int LDS_BYTES = 147456;
#ifndef PH
#define PH 0xffff
#endif
#ifndef SYNC_REP
#define SYNC_REP 1
#endif
#ifndef ATT_REP
#define ATT_REP 1
#endif
#ifndef ROW_REP
#define ROW_REP 1
#endif
#define GRID_SYNC() do { for (int r_ = 0; r_ < SYNC_REP; ++r_) xcd_barrier(bar); } while (0)

struct Args {
    const void* in[23];
    float* out;
    unsigned char* ws;
    float invf[32];
    float lam_init[4];
};
static_assert(sizeof(Args) % 8 == 0, "no tail padding");

typedef float f32x2_t __attribute__((ext_vector_type(2))); typedef __bf16 bf16x2_t __attribute__((ext_vector_type(2)));
__device__ __forceinline__ unsigned cvtpk(float lo, float hi) { f32x2_t v = {lo, hi}; bf16x2_t b = __builtin_convertvector(v, bf16x2_t); return __builtin_bit_cast(unsigned, b); }
__device__ __forceinline__ float bflo(unsigned w) { return __uint_as_float(w << 16); }
__device__ __forceinline__ float bfhi(unsigned w) { return __uint_as_float(w & 0xffff0000u); }
__device__ __forceinline__ float wave_sum(float v) {
#pragma unroll
    for (int o = 1; o < 64; o <<= 1) v += __shfl_xor(v, o);
    return v;
}
__device__ __forceinline__ float sigmoidf_(float x) { return __builtin_amdgcn_rcpf(1.0f + __expf(-x)); }

namespace pg8 {
typedef f32x4 (acc_t)[2][2][4][2];
__device__ __forceinline__ u32x4 pack8(const f32x4 v0, const f32x4 v1) { u32x4 w; w.x = cvtpk(v0[0], v0[1]); w.y = cvtpk(v0[2], v0[3]); w.z = cvtpk(v1[0], v1[1]); w.w = cvtpk(v1[2], v1[3]); return w; }
__device__ __forceinline__ void unpack8(const u32x4 w, f32x4& v0, f32x4& v1) { v0 = (f32x4){bflo(w.x), bfhi(w.x), bflo(w.y), bfhi(w.y)}; v1 = (f32x4){bflo(w.z), bfhi(w.z), bflo(w.w), bfhi(w.w)}; }

struct EpiPlain {
    static constexpr bool PERM = true, AFTER_DRAIN = false;
    bf16_t* O; int ldc;
    __device__ __forceinline__ void operator()(const f32x4 (&acc)[2][2][4][2], const Unit& u, int wr, int wc, int fr, int fq) const {
        const int row0 = u.pm * BM + wr * 64 + fr, col0 = u.pn * BM + wc * 32 + 8 * fq;
#pragma unroll
        for (int ai = 0; ai < 2; ++ai)
#pragma unroll
            for (int m = 0; m < 4; ++m) { bf16_t* rowp = O + (size_t)(row0 + ai * HALF + m * 16) * ldc + col0;
#pragma unroll
                for (int bj = 0; bj < 2; ++bj) *(u32x4*)(rowp + bj * HALF) = pack8(acc[ai][bj][m][0], acc[ai][bj][m][1]); }
    }
};
struct EpiSwiglu {
    static constexpr bool PERM = true, AFTER_DRAIN = false;
    bf16_t* O; const float* rs;
    __device__ __forceinline__ void operator()(const f32x4 (&acc)[2][2][4][2], const Unit& u, int wr, int wc, int fr, int fq) const {
        const int row0 = u.pm * BM + wr * 64 + fr, col0 = u.pn * HALF + wc * 32 + 8 * fq;
#pragma unroll
        for (int ai = 0; ai < 2; ++ai)
#pragma unroll
            for (int m = 0; m < 4; ++m) { bf16_t* rowp = O + (size_t)(row0 + ai * HALF + m * 16) * DFF + col0; const float rv = rs[row0 + ai * HALF + m * 16];
                f32x4 o[2];
#pragma unroll
                for (int n = 0; n < 2; ++n) { const f32x4 g = acc[ai][0][m][n] * rv, uu = acc[ai][1][m][n] * rv;
#pragma unroll
                    for (int e = 0; e < 4; ++e) o[n][e] = g[e] * sigmoidf_(g[e]) * uu[e]; }
                *(u32x4*)rowp = pack8(o[0], o[1]); }
    }
};
struct EpiWin {
    static constexpr bool PERM = true, AFTER_DRAIN = false;
    bf16_t* R; const float* rope; const float* rs;
    __device__ __forceinline__ void operator()(const f32x4 (&acc)[2][2][4][2], const Unit& u, int wr, int wc, int fr, int fq) const {
        const int pn = u.pn, row0 = u.pm * BM + wr * 64 + fr, cl = wc * 32 + 8 * fq;
        if (pn < 12) {
            const int sec = pn >> 1;
            bf16_t* base = R + (size_t)sec * ((size_t)M * 512) + (pn & 1) * 256 + cl;
            const float sc = (sec == 0) ? 0.125f : ((sec == 3) ? 0.125f * 1.4426950408889634f : 1.0f);
            const bool rp = (sec == 3) || (sec == 4);
#pragma unroll
            for (int ai = 0; ai < 2; ++ai)
#pragma unroll
                for (int m = 0; m < 4; ++m) { const int row = row0 + ai * HALF + m * 16; const float scr_ = sc * rs[row];
                    f32x4 cs0 = {1.f, 0.f, 1.f, 0.f}, cs1 = {1.f, 0.f, 1.f, 0.f};
                    if (rp) { const float* rt = rope + (size_t)row * 64 + (16 * (wc & 1) + 4 * fq) * 2; cs0 = *(const f32x4*)rt; cs1 = *(const f32x4*)(rt + 4); }
                    const f32x4 cc = {cs0[0], cs0[2], cs1[0], cs1[2]}, ss = {cs0[1], cs0[3], cs1[1], cs1[3]};
#pragma unroll
                    for (int bj = 0; bj < 2; ++bj) { const f32x4 x1 = acc[ai][bj][m][0] * scr_, x2 = acc[ai][bj][m][1] * scr_;
                        const f32x4 y1 = x1 * cc - x2 * ss, y2 = x2 * cc + x1 * ss;
                        *(u32x4*)(base + (size_t)row * 512 + bj * HALF) = pack8(y1, y2); } }
        } else {
            const int t = pn - 12;
            bf16_t* base = R + (size_t)6 * ((size_t)M * 512) + (size_t)(t >> 2) * ((size_t)M * 1024) + (t & 3) * 256 + cl;
#pragma unroll
            for (int ai = 0; ai < 2; ++ai)
#pragma unroll
                for (int m = 0; m < 4; ++m) { const int row = row0 + ai * HALF + m * 16; const float rv = rs[row];
#pragma unroll
                    for (int bj = 0; bj < 2; ++bj) { f32x4 v0 = acc[ai][bj][m][0] * rv, v1 = acc[ai][bj][m][1] * rv;
#pragma unroll
                        for (int e = 0; e < 4; ++e) { v0[e] = sigmoidf_(v0[e]); v1[e] = sigmoidf_(v1[e]); }
                        *(u32x4*)(base + (size_t)row * 1024 + bj * HALF) = pack8(v0, v1); } }
        }
    }
};
template <int MODE> struct EpiTwo {
    static constexpr bool PERM = true, AFTER_DRAIN = false;
    bf16_t* tmp; const bf16_t* G; bf16_t* O; const float* rs;
    __device__ __forceinline__ void operator()(const f32x4 (&acc)[2][2][4][2], const Unit& u, int wr, int wc, int fr, int fq) const {
        const int row0 = u.pm * BM + wr * 64 + fr, col0 = u.pn * BM + wc * 32 + 8 * fq;
#pragma unroll
        for (int ai = 0; ai < 2; ++ai)
#pragma unroll
            for (int m = 0; m < 4; ++m) { const size_t off = (size_t)(row0 + ai * HALF + m * 16) * 1024 + col0; const float rv = (MODE == 2) ? rs[row0 + ai * HALF + m * 16] : 1.0f;
#pragma unroll
                for (int bj = 0; bj < 2; ++bj) { f32x4 v0 = acc[ai][bj][m][0] * rv, v1 = acc[ai][bj][m][1] * rv; const size_t o2 = off + bj * HALF;
                    if (MODE == 0 || MODE == 1) { f32x4 g0, g1; unpack8(*(const u32x4*)(G + o2), g0, g1); v0 = v0 * g0; v1 = v1 * g1; }
                    if (MODE == 2) {
#pragma unroll
                        for (int e = 0; e < 4; ++e) { v0[e] = sigmoidf_(v0[e]); v1[e] = sigmoidf_(v1[e]); } }
                    if (MODE == 0 || MODE == 2) { *(u32x4*)(tmp + o2) = pack8(v0, v1); }
                    else { f32x4 t0, t1; unpack8(*(const u32x4*)(tmp + o2), t0, t1);
                        if (MODE == 1) { v0 = v0 + t0; v1 = v1 + t1; } else { v0 = v0 * t0; v1 = v1 * t1; }
                        *(u32x4*)(O + o2) = pack8(v0, v1); } } }
    }
};
}

namespace att {
#define MFMA32(a, b, c) __builtin_amdgcn_mfma_f32_32x32x16_bf16((a), (b), (c), 0, 0, 0)
typedef short v4i16_t __attribute__((ext_vector_type(4)));
__device__ __forceinline__ int crow(int r, int hi) { return (r & 3) + 8 * (r >> 2) + 4 * hi; }
__device__ __forceinline__ s16x4 vtr(LAS const unsigned char* p) { return __builtin_bit_cast(s16x4, __builtin_amdgcn_ds_read_tr16_b64_v4i16((LAS v4i16_t*)p)); }
__device__ __forceinline__ bf16x8 cat8(s16x4 a, s16x4 b) { return (bf16x8){a[0], a[1], a[2], a[3], b[0], b[1], b[2], b[3]}; }
__device__ __forceinline__ bf16x8 packp(const f32x16& p, int s) { u32x4 w; w.x = cvtpk(p[8 * s], p[8 * s + 1]); w.y = cvtpk(p[8 * s + 2], p[8 * s + 3]); w.z = cvtpk(p[8 * s + 4], p[8 * s + 5]); w.w = cvtpk(p[8 * s + 6], p[8 * s + 7]); return __builtin_bit_cast(bf16x8, w); }

__device__ __forceinline__ void df_unit(LAS unsigned char* lds, int b, int h, int qb, const bf16_t* __restrict__ Q, const bf16_t* __restrict__ K, const bf16_t* __restrict__ V, bf16_t* __restrict__ O,
                                        float lam, float oscale, const float* __restrict__ subg) {
    int tid_ = threadIdx.x; asm volatile("" : "+v"(tid_));
    const int tid = tid_, lane = tid & 63, wid = __builtin_amdgcn_readfirstlane(tid >> 6), r32 = lane & 31, hi = lane >> 5;
    const int c = wid >> 2, wq = wid & 3;
    const size_t rowbase = (size_t)b * SEQ;
    const int q0 = qb * 128, qw0 = q0 + 32 * wq, NT = (q0 + 128) / 64;
    const bf16_t* kg = K + (rowbase + lane) * 512 + h * 128 + wid * 8;
    const bf16_t* vg = V + (rowbase + 16 * (wid & 3) + (lane >> 2)) * 512 + h * 128 + (wid >> 2) * 32 + (lane & 3) * 8;
    u32x4 rk1, rk2, rv0, rv1;
#define DF_LOAD(t) do { const size_t off_ = (size_t)(t) * 64 * 512; rk1 = *(const u32x4*)(kg + off_); rk2 = *(const u32x4*)(kg + off_ + 64); rv0 = *(const u32x4*)(vg + off_); rv1 = *(const u32x4*)(vg + off_ + 64); } while (0)
#define DF_STORE(s) do { LAS unsigned char* sb_ = lds + (s) * 32768 + wid * 1024 + lane * 16; *(LAS u32x4*)(sb_) = rk1; *(LAS u32x4*)(sb_ + 8192) = rk2; *(LAS u32x4*)(sb_ + 16384) = rv0; *(LAS u32x4*)(sb_ + 24576) = rv1; } while (0)
    bf16x8 qr[4];
    { const bf16_t* qp = Q + (rowbase + qw0 + r32) * 512 + h * 128 + c * 64 + hi * 8;
#pragma unroll
      for (int d0 = 0; d0 < 4; ++d0) qr[d0] = *(const bf16x8*)(qp + d0 * 16); }
    float m_run = -1e30f, l_run = 0.f;
    f32x16 o[4];
#pragma unroll
    for (int d = 0; d < 4; ++d) o[d] = (f32x16){};
    DF_LOAD(0); DF_STORE(0); __syncthreads();
    for (int kt = 0; kt < NT; ++kt) {
        const int s = kt & 1;
        if (kt + 1 < NT) DF_LOAD(kt + 1);
        if (64 * kt <= qw0 + 31) {
            LAS const unsigned char* kb = lds + s * 32768 + c * 8192 + hi * 1024 + r32 * 16;
            f32x16 p0 = (f32x16){}, p1 = (f32x16){};
#pragma unroll
            for (int d0 = 0; d0 < 4; ++d0) { const bf16x8 a0 = *(LAS const bf16x8*)(kb + d0 * 2048), a1 = *(LAS const bf16x8*)(kb + d0 * 2048 + 512);
                p0 = MFMA32(a0, qr[d0], p0); p1 = MFMA32(a1, qr[d0], p1); }
            if (64 * kt + 63 > qw0) { const int q = qw0 + r32, kb0 = 64 * kt + 4 * hi;
#pragma unroll
                for (int r = 0; r < 16; ++r) { const int key = kb0 + (r & 3) + 8 * (r >> 2); if (key > q) p0[r] = -INFINITY; if (key + 32 > q) p1[r] = -INFINITY; } }
            float mx = fmaxf(p0[0], p1[0]);
#pragma unroll
            for (int r = 1; r < 16; ++r) mx = fmaxf(mx, fmaxf(p0[r], p1[r]));
            mx = fmaxf(mx, __shfl_xor(mx, 32));
            const bool grow = mx > m_run + 8.0f;
            const float mn = grow ? mx : m_run, sc = __builtin_amdgcn_exp2f(m_run - mn);
            m_run = mn;
            float rs = 0.f;
#pragma unroll
            for (int r = 0; r < 16; ++r) { p0[r] = __builtin_amdgcn_exp2f(p0[r] - mn); p1[r] = __builtin_amdgcn_exp2f(p1[r] - mn); rs += p0[r] + p1[r]; }
            rs += __shfl_xor(rs, 32);
            l_run = l_run * sc + rs;
            if (__any(grow)) {
#pragma unroll
                for (int r = 0; r < 16; ++r) { const float f = __shfl(sc, crow(r, hi));
#pragma unroll
                    for (int d = 0; d < 4; ++d) o[d][r] *= f; }
            }
            bf16x8 pa[4]; pa[0] = packp(p0, 0); pa[1] = packp(p0, 1); pa[2] = packp(p1, 0); pa[3] = packp(p1, 1);
            LAS const unsigned char* vb = lds + s * 32768 + 16384 + ((lane >> 4) & 1) * 32 + (lane & 3) * 8 + (4 * hi + ((lane & 15) >> 2)) * 64;
#pragma unroll
            for (int d = 0; d < 4; ++d)
#pragma unroll
                for (int ks = 0; ks < 4; ++ks) { const s16x4 lo = vtr(vb + (d * 4 + ks) * 1024), hh = vtr(vb + (d * 4 + ks) * 1024 + 512); o[d] = MFMA32(pa[ks], cat8(lo, hh), o[d]); }
        }
        if (kt + 1 < NT) DF_STORE(s ^ 1);
        __syncthreads();
    }
#undef DF_LOAD
#undef DF_STORE
    LAS float* ob = (LAS float*)lds;
    const float linv_own = 1.0f / l_run;
    const float wgt = (c == 1) ? -lam : 1.0f;
    if (c == 1) {
#pragma unroll
        for (int r = 0; r < 16; ++r) { const float f = __shfl(linv_own, crow(r, hi)) * wgt; const int row = 32 * wq + crow(r, hi);
#pragma unroll
            for (int d = 0; d < 4; ++d) ob[row * 132 + 32 * d + r32] = o[d][r] * f; }
    }
    __syncthreads();
    if (c == 0) {
#pragma unroll
        for (int r = 0; r < 16; ++r) { const float f = __shfl(linv_own, crow(r, hi)); const int row = 32 * wq + crow(r, hi);
#pragma unroll
            for (int d = 0; d < 4; ++d) ob[row * 132 + 32 * d + r32] += o[d][r] * f; }
    }
    __syncthreads();
    { const int row = tid >> 2, part = tid & 3; const LAS float* rp = ob + row * 132 + part * 32;
      f32x4 v[8]; float ss = 0.f;
#pragma unroll
      for (int j = 0; j < 8; ++j) { v[j] = *(const LAS f32x4*)(rp + 4 * j); ss += (v[j][0] * v[j][0] + v[j][1] * v[j][1]) + (v[j][2] * v[j][2] + v[j][3] * v[j][3]); }
      ss += __shfl_xor(ss, 1); ss += __shfl_xor(ss, 2);
      const float rn = oscale / sqrtf(ss * (1.0f / 128.0f) + 1e-5f);
      bf16_t* op = O + (rowbase + q0 + row) * 512 + h * 128 + part * 32;
#pragma unroll
      for (int j = 0; j < 4; ++j) { const f32x4 g0 = *(const f32x4*)(subg + part * 32 + 8 * j), g1 = *(const f32x4*)(subg + part * 32 + 8 * j + 4);
          const f32x4 a = v[2 * j] * g0 * rn, bb = v[2 * j + 1] * g1 * rn;
          u32x4 w; w.x = cvtpk(a[0], a[1]); w.y = cvtpk(a[2], a[3]); w.z = cvtpk(bb[0], bb[1]); w.w = cvtpk(bb[2], bb[3]);
          *(u32x4*)(op + 8 * j) = w; } }
    __syncthreads();
}

__device__ __forceinline__ void sb_unit(LAS unsigned char* lds, int b, int h, int qb, const bf16_t* __restrict__ Q, const bf16_t* __restrict__ K, const bf16_t* __restrict__ V, bf16_t* __restrict__ O) {
    int tid_ = threadIdx.x; asm volatile("" : "+v"(tid_));
    const int tid = tid_, lane = tid & 63, wid = __builtin_amdgcn_readfirstlane(tid >> 6), r32 = lane & 31, hi = lane >> 5;
    const size_t rowbase = (size_t)b * SEQ;
    const int q0 = qb * 256, qw0 = q0 + 32 * wid, kt_hi = (q0 + 256) / 64 - 1;
    const bf16_t* kg = K + (rowbase + lane) * 512 + h * 64 + wid * 8;
    const bf16_t* vg = V + (rowbase + 16 * (wid & 3) + (lane >> 2)) * 512 + h * 64 + (wid >> 2) * 32 + (lane & 3) * 8;
    LAS unsigned* flags = (LAS unsigned*)(lds + 32768);
    LAS unsigned char* ost = lds + 36864 + wid * 4608;
    u32x4 rk, rv;
#define SB_LOAD(t) do { const size_t off_ = (size_t)(t) * 64 * 512; rk = *(const u32x4*)(kg + off_); rv = *(const u32x4*)(vg + off_); } while (0)
#define SB_STORE(s) do { LAS unsigned char* sb_ = lds + (s) * 16384 + wid * 1024 + lane * 16; *(LAS u32x4*)(sb_) = rk; *(LAS u32x4*)(sb_ + 8192) = rv; } while (0)
    bf16x8 qr[4];
    { const bf16_t* qp = Q + (rowbase + qw0 + r32) * 512 + h * 64 + hi * 8;
#pragma unroll
      for (int d0 = 0; d0 < 4; ++d0) qr[d0] = *(const bf16x8*)(qp + d0 * 16); }
    float carry = 0.f; bool done = false;
    f32x16 o[2]; o[0] = (f32x16){}; o[1] = (f32x16){};
    SB_LOAD(kt_hi); SB_STORE(0); __syncthreads();
    int it = 0;
    for (int kt = kt_hi; kt >= 0; --kt, ++it) {
        const int s = it & 1;
        if (kt > 0) SB_LOAD(kt - 1);
        if (!done && 64 * kt < qw0 + 31) {
            LAS const unsigned char* kb = lds + s * 16384 + hi * 1024 + r32 * 16;
            f32x16 p0 = (f32x16){}, p1 = (f32x16){};
#pragma unroll
            for (int d0 = 0; d0 < 4; ++d0) { const bf16x8 a0 = *(LAS const bf16x8*)(kb + d0 * 2048), a1 = *(LAS const bf16x8*)(kb + d0 * 2048 + 512);
                p0 = MFMA32(a0, qr[d0], p0); p1 = MFMA32(a1, qr[d0], p1); }
            const int q = qw0 + r32, kb0 = 64 * kt + 4 * hi;
            f32x16 L0, L1;
#pragma unroll
            for (int r = 0; r < 16; ++r) { const int key = kb0 + (r & 3) + 8 * (r >> 2);
                { const float z = p0[r], sp = fmaxf(z, 0.f) + __logf(1.0f + __expf(-fabsf(z))); const bool v = key < q; L0[r] = v ? -sp : 0.f; p0[r] = v ? (z - sp) : -1e30f; }
                { const float z = p1[r], sp = fmaxf(z, 0.f) + __logf(1.0f + __expf(-fabsf(z))); const bool v = (key + 32) < q; L1[r] = v ? -sp : 0.f; p1[r] = v ? (z - sp) : -1e30f; } }
            float own[8], par[8], S[8];
#pragma unroll
            for (int j = 0; j < 4; ++j) { own[j] = (L0[4 * j] + L0[4 * j + 1]) + (L0[4 * j + 2] + L0[4 * j + 3]); own[4 + j] = (L1[4 * j] + L1[4 * j + 1]) + (L1[4 * j + 2] + L1[4 * j + 3]); }
#pragma unroll
            for (int j = 0; j < 8; ++j) par[j] = __shfl_xor(own[j], 32);
            S[7] = 0.f;
#pragma unroll
            for (int j = 6; j >= 0; --j) S[j] = S[j + 1] + (own[j + 1] + par[j + 1]);
            const float total = S[0] + (own[0] + par[0]);
#pragma unroll
            for (int j = 0; j < 8; ++j) { const float lg = carry + S[j] + (hi == 0 ? par[j] : 0.f);
                if (j < 4) { const int rb = 4 * j; const float l3 = lg, l2 = l3 + L0[rb + 3], l1 = l2 + L0[rb + 2], l0 = l1 + L0[rb + 1];
                    p0[rb] = __expf(p0[rb] + l0); p0[rb + 1] = __expf(p0[rb + 1] + l1); p0[rb + 2] = __expf(p0[rb + 2] + l2); p0[rb + 3] = __expf(p0[rb + 3] + l3); }
                else { const int rb = 4 * (j - 4); const float l3 = lg, l2 = l3 + L1[rb + 3], l1 = l2 + L1[rb + 2], l0 = l1 + L1[rb + 1];
                    p1[rb] = __expf(p1[rb] + l0); p1[rb + 1] = __expf(p1[rb + 1] + l1); p1[rb + 2] = __expf(p1[rb + 2] + l2); p1[rb + 3] = __expf(p1[rb + 3] + l3); } }
            carry += total;
            bf16x8 pa[4]; pa[0] = packp(p0, 0); pa[1] = packp(p0, 1); pa[2] = packp(p1, 0); pa[3] = packp(p1, 1);
            LAS const unsigned char* vb = lds + s * 16384 + 8192 + ((lane >> 4) & 1) * 32 + (lane & 3) * 8 + (4 * hi + ((lane & 15) >> 2)) * 64;
#pragma unroll
            for (int d = 0; d < 2; ++d)
#pragma unroll
                for (int ks = 0; ks < 4; ++ks) { const s16x4 lo = vtr(vb + (d * 4 + ks) * 1024), hh = vtr(vb + (d * 4 + ks) * 1024 + 512); o[d] = MFMA32(pa[ks], cat8(lo, hh), o[d]); }
            done = __all(carry < -104.0f) != 0;
        }
        if (lane == 0) flags[s * 8 + wid] = done ? 1u : 0u;
        if (kt > 0) SB_STORE(s ^ 1);
        __syncthreads();
        unsigned all = 1u;
#pragma unroll
        for (int w = 0; w < 8; ++w) all &= flags[s * 8 + w];
        if (all) break;
    }
#undef SB_LOAD
#undef SB_STORE
#pragma unroll
    for (int d = 0; d < 2; ++d)
#pragma unroll
        for (int r = 0; r < 16; r += 2) { const unsigned w = cvtpk(o[d][r], o[d][r + 1]);
            *(LAS unsigned short*)(ost + crow(r, hi) * 144 + (32 * d + r32) * 2) = (unsigned short)(w & 0xffffu);
            *(LAS unsigned short*)(ost + crow(r + 1, hi) * 144 + (32 * d + r32) * 2) = (unsigned short)(w >> 16); }
    asm volatile("s_waitcnt lgkmcnt(0)" ::: "memory");
#pragma unroll
    for (int j = 0; j < 4; ++j) { const int idx = lane + 64 * j, row = idx >> 3, ch = idx & 7;
        const u32x4 w = *(LAS const u32x4*)(ost + row * 144 + ch * 16);
        *(u32x4*)(O + (rowbase + qw0 + row) * 512 + h * 64 + ch * 8) = w; }
    __syncthreads();
}
}

__device__ __forceinline__ int dest_row(int mode, int c) {
    if (mode == 1) { return (c < DFF) ? (256 * (c >> 7) + (c & 127)) : (256 * ((c - DFF) >> 7) + 128 + ((c - DFF) & 127)); }
    if (mode == 2) { if (c >= 1536 && c < 2560) { const int j = c & 63, half = j >> 5, q = (j & 31) >> 2, e = j & 3; return (c & ~63) + 8 * q + 4 * half + e; } return c; }
    return c;
}
__device__ __forceinline__ void transpose_item(const float* __restrict__ W, int K, int N, bf16_t* __restrict__ WT, int mode, LAS float* scr, int item, int lane, const float* __restrict__ gk = nullptr) {
    const int nblk = N / 32, kb = item / nblk, nb = item % nblk, k0 = 64 * kb, n0 = 32 * nb;
#pragma unroll 8
    for (int i = 0; i < 32; ++i) { const int kk = 2 * i + (lane >> 5); const float gg = gk ? gk[k0 + kk] : 1.0f; scr[kk * 33 + (lane & 31)] = W[(size_t)(k0 + kk) * N + n0 + (lane & 31)] * gg; }
    asm volatile("s_waitcnt lgkmcnt(0)" ::: "memory");
    const int c = lane & 7;
#pragma unroll
    for (int j = 0; j < 4; ++j) { const int n = (lane >> 3) + 8 * j; const LAS float* s = scr + (8 * c) * 33 + n;
        u32x4 o; o.x = cvtpk(s[0 * 33], s[1 * 33]); o.y = cvtpk(s[2 * 33], s[3 * 33]); o.z = cvtpk(s[4 * 33], s[5 * 33]); o.w = cvtpk(s[6 * 33], s[7 * 33]);
        *(u32x4*)(WT + (size_t)dest_row(mode, n0 + n) * K + k0 + 8 * c) = o; }
    asm volatile("s_waitcnt lgkmcnt(0)" ::: "memory");
}

template <int MODE>
__device__ __forceinline__ void row_pass(const float* __restrict__ xin, bf16_t* __restrict__ H, const bf16_t* __restrict__ F, float coef, const float* __restrict__ gpost, float* __restrict__ rs,
                                         float* __restrict__ fout, int gw, int NGW, int lane_in) {
    int lane = lane_in; asm volatile("" : "+v"(lane));
    f32x4 gp[4];
#pragma unroll
    for (int j = 0; j < 4; ++j) gp[j] = (MODE != 0) ? *(const f32x4*)(gpost + 256 * j + 4 * lane) : (f32x4){0.f, 0.f, 0.f, 0.f};
    for (int m = gw; m < M; m += NGW) {
        f32x4 hv[4];
        if (MODE == 0) {
#pragma unroll
            for (int j = 0; j < 4; ++j) hv[j] = *(const f32x4*)(xin + (size_t)m * DM + 256 * j + 4 * lane);
        } else {
            f32x4 fv[4]; float ss = 0.f;
#pragma unroll
            for (int j = 0; j < 4; ++j) { const u32x2 w = *(const u32x2*)(F + (size_t)m * DM + 256 * j + 4 * lane); fv[j] = (f32x4){bflo(w.x), bfhi(w.x), bflo(w.y), bfhi(w.y)};
                const u32x2 hw = *(const u32x2*)(H + (size_t)m * DM + 256 * j + 4 * lane); hv[j] = (f32x4){bflo(hw.x), bfhi(hw.x), bflo(hw.y), bfhi(hw.y)};
                ss += (fv[j][0] * fv[j][0] + fv[j][1] * fv[j][1]) + (fv[j][2] * fv[j][2] + fv[j][3] * fv[j][3]); }
            const float r = coef / sqrtf(wave_sum(ss) * (1.0f / DM) + 1e-6f);
#pragma unroll
            for (int j = 0; j < 4; ++j) hv[j] = hv[j] + fv[j] * gp[j] * r;
        }
        if (MODE == 2) {
#pragma unroll
            for (int j = 0; j < 4; ++j) *(f32x4*)(fout + (size_t)m * DM + 256 * j + 4 * lane) = hv[j];
        } else {
            float s2 = 0.f;
#pragma unroll
            for (int j = 0; j < 4; ++j) { s2 += (hv[j][0] * hv[j][0] + hv[j][1] * hv[j][1]) + (hv[j][2] * hv[j][2] + hv[j][3] * hv[j][3]);
                u32x2 w; w.x = cvtpk(hv[j][0], hv[j][1]); w.y = cvtpk(hv[j][2], hv[j][3]); *(u32x2*)(H + (size_t)m * DM + 256 * j + 4 * lane) = w; }
            const float r2 = 1.0f / sqrtf(wave_sum(s2) * (1.0f / DM) + 1e-6f);
            if (lane == 0) rs[m] = r2;
        }
    }
}

#define XB_TMO      128
#define XB_XCNT(j)  (256  + 64 * (j))
#define XB_XSUB(j)  (1280 + 64 * (j))
#define XB_XGEN(j)  (2304 + 64 * (j))
#define XB_TOP      3328
#define XB_TOPGEN   3392
#define XCD_BAR_WORDS 3456
#define XB_SPIN_CAP (1u << 18)

__device__ __forceinline__ unsigned xb_ld(unsigned* p)              { return __hip_atomic_load(p, __ATOMIC_RELAXED, __HIP_MEMORY_SCOPE_AGENT); }
__device__ __forceinline__ unsigned xb_add(unsigned* p, unsigned v) { return __hip_atomic_fetch_add(p, v, __ATOMIC_RELAXED, __HIP_MEMORY_SCOPE_AGENT); }
__device__ __forceinline__ unsigned xb_xcc_id() { return (unsigned)__builtin_amdgcn_s_getreg((3 << 11) | 20) & 0xFu; }
#define XB_SPIN(cond, bar) do { unsigned _sp = 0; while (cond) { __builtin_amdgcn_s_sleep(1); \
    if ((++_sp & 255u) == 0u) { if (xb_ld(&(bar)[XB_TMO])) break; if (_sp > XB_SPIN_CAP) { atomicAdd(&(bar)[XB_TMO], 1u); break; } } } } while (0)

struct XcdBarrier {
    unsigned* bar; unsigned x;
    volatile LAS unsigned* st;
};

__device__ __forceinline__ XcdBarrier xcd_barrier_post(unsigned* bar, volatile LAS unsigned* st) {
    XcdBarrier b; b.bar = bar; b.x = xb_xcc_id(); b.st = st;
    if (threadIdx.x == 0) (void)xb_add(&bar[XB_XCNT(b.x)], 1u);
    return b;
}
__device__ __forceinline__ void xcd_barrier_complete(unsigned* bar, unsigned x, unsigned& nloc, unsigned& nx) {
    const unsigned G = gridDim.x * gridDim.y * gridDim.z;
    unsigned sum, cnt, mine, sp = 0u;
    for (;;) {
        sum = 0u; cnt = 0u; mine = 0u;
#pragma unroll
        for (unsigned j = 0; j < 16; ++j) { const unsigned c = xb_ld(&bar[XB_XCNT(j)]); sum += c; cnt += (c > 0u) ? 1u : 0u; mine = (j == x) ? c : mine; }
        if (sum == G) break;
        __builtin_amdgcn_s_sleep(1);
        if ((++sp & 255u) == 0u) { if (xb_ld(&bar[XB_TMO])) break; if (sp > XB_SPIN_CAP) { atomicAdd(&bar[XB_TMO], 1u); break; } }
    }
    nloc = mine > 0u ? mine : 1u; nx = cnt > 0u ? cnt : 1u;
}

__device__ __forceinline__ void xcd_barrier(const XcdBarrier& b) {
    asm volatile("s_waitcnt vmcnt(0)" ::: "memory");
    __syncthreads();
    if (threadIdx.x == 0) {
        unsigned* bar = b.bar;
        __builtin_amdgcn_s_waitcnt(0);
        unsigned nloc = b.st[0], nx = b.st[1];
        if (nloc == 0u) { xcd_barrier_complete(bar, b.x, nloc, nx); b.st[0] = nloc; b.st[1] = nx; }
        const unsigned old = xb_add(&bar[XB_XSUB(b.x)], 1u);
        const unsigned gen = old / nloc;
        if (old + 1u == (gen + 1u) * nloc) {
            __builtin_amdgcn_fence(__ATOMIC_RELEASE, "agent");
            asm volatile("s_waitcnt vmcnt(0)" ::: "memory");
            const unsigned og = xb_add(&bar[XB_TOP], 1u);
            const unsigned tg = og / nx;
            if (og + 1u == (tg + 1u) * nx) xb_add(&bar[XB_TOPGEN], 1u);
            else XB_SPIN(xb_ld(&bar[XB_TOPGEN]) == tg, bar);
            __builtin_amdgcn_fence(__ATOMIC_ACQUIRE, "agent");
            xb_add(&bar[XB_XGEN(b.x)], 1u);
            asm volatile("s_waitcnt vmcnt(0)" ::: "memory");
        } else {
            XB_SPIN(xb_ld(&bar[XB_XGEN(b.x)]) == gen, bar);
            __builtin_amdgcn_fence(__ATOMIC_ACQUIRE, "agent");
            asm volatile("s_waitcnt vmcnt(0)" ::: "memory");
        }
    }
    __syncthreads();
}


__global__ void __launch_bounds__(512, 2) fwd_megakernel(Args a) {
    extern __shared__ __attribute__((aligned(16))) unsigned char lds_raw[];
    LAS unsigned char* lds = (LAS unsigned char*)lds_raw;
    cg::grid_group grid = cg::this_grid();
    const int tid = threadIdx.x, lane = tid & 63, wave = __builtin_amdgcn_readfirstlane(tid >> 6);
    const int G = gridDim.x, bx = blockIdx.x, vcu = (G % 8 == 0) ? (bx % 8) * (G / 8) + bx / 8 : bx;
    const int gw = vcu * 8 + wave, NGW = G * 8;
    unsigned char* ws = a.ws;
    if (tid < 16) ((LAS unsigned*)(lds + LDS_MISC))[tid] = 0u;
    __syncthreads();
    XcdBarrier bar = xcd_barrier_post((unsigned*)(ws + WS_CTL), (volatile LAS unsigned*)(lds + LDS_MISC));
    const float* x = (const float*)a.in[0];
    const float* pin = (const float*)a.in[1];
    const int* positions = (const int*)a.in[2];
    bf16_t* U = (bf16_t*)(ws + WS_U);
    float* RS = (float*)(ws + WS_CTL + 65536);
    bf16_t* F = (bf16_t*)(ws + WS_F);
    bf16_t* PB = (bf16_t*)(ws + WS_P);
    float* rope = (float*)(ws + WS_ROPE);
    bf16_t* R = (bf16_t*)(ws + WS_R);
    bf16_t* ACT = (bf16_t*)(ws + WS_R + R_ACT);
    bf16_t* TMP = (bf16_t*)(ws + WS_R + R_TMP);
    bf16_t* MRG = (bf16_t*)(ws + WS_R + R_MRG);
    bf16_t* GSB = (bf16_t*)(ws + WS_R + R_GSB);
    bf16_t* GDF = (bf16_t*)(ws + WS_R + R_GDF);
    bf16_t* OSB = (bf16_t*)(ws + WS_R + R_OSB);
    bf16_t* ODF = (bf16_t*)(ws + WS_R + R_ODF);

    if (PH & 1) {
        LAS float* scr = (LAS float*)(lds + wave * 16384);
        constexpr int I_GU = (DM / 64) * (2 * DFF / 32), I_D = (DFF / 64) * (DM / 32), I_IN = (DM / 64) * (DIN / 32), I_B = (512 / 64) * (DM / 32), I_O = (DM / 64) * (DM / 32), I_PP = (PLE / 64) * (DM / 32);
        constexpr int I_LAYER = 2 * I_GU + 2 * I_D + I_IN + 2 * I_B + 2 * I_O + I_PP;
        for (int it = gw; it < DEPTH * I_LAYER; it += NGW) {
            const int L = it / I_LAYER; int r = it % I_LAYER;
            bf16_t* wl = (bf16_t*)(ws + WS_W + (size_t)L * LAYER_W);
            if (r < I_GU) { transpose_item((const float*)a.in[4] + (size_t)L * DM * 2 * DFF, DM, 2 * DFF, wl + O_WGU1 / 2, 1, scr, r, lane, (const float*)a.in[3] + (size_t)L * DM); continue; } r -= I_GU;
            if (r < I_D) { transpose_item((const float*)a.in[5] + (size_t)L * DFF * DM, DFF, DM, wl + O_WD1 / 2, 0, scr, r, lane); continue; } r -= I_D;
            if (r < I_IN) { transpose_item((const float*)a.in[8] + (size_t)L * DM * DIN, DM, DIN, wl + O_WIN / 2, 2, scr, r, lane, (const float*)a.in[7] + (size_t)L * DM); continue; } r -= I_IN;
            if (r < I_B) { transpose_item((const float*)a.in[11] + (size_t)L * 512 * DM, 512, DM, wl + O_WBS / 2, 0, scr, r, lane); continue; } r -= I_B;
            if (r < I_B) { transpose_item((const float*)a.in[12] + (size_t)L * 512 * DM, 512, DM, wl + O_WBD / 2, 0, scr, r, lane); continue; } r -= I_B;
            if (r < I_O) { transpose_item((const float*)a.in[13] + (size_t)L * DM * DM, DM, DM, wl + O_WOUT / 2, 0, scr, r, lane); continue; } r -= I_O;
            if (r < I_GU) { transpose_item((const float*)a.in[16] + (size_t)L * DM * 2 * DFF, DM, 2 * DFF, wl + O_WGU2 / 2, 1, scr, r, lane, (const float*)a.in[15] + (size_t)L * DM); continue; } r -= I_GU;
            if (r < I_D) { transpose_item((const float*)a.in[17] + (size_t)L * DFF * DM, DFF, DM, wl + O_WD2 / 2, 0, scr, r, lane); continue; } r -= I_D;
            if (r < I_O) { transpose_item((const float*)a.in[20] + (size_t)L * DM * DM, DM, DM, wl + O_WPG / 2, 0, scr, r, lane, (const float*)a.in[19] + (size_t)L * DM); continue; } r -= I_O;
            transpose_item((const float*)a.in[21] + (size_t)L * PLE * DM, PLE, DM, wl + O_WPP / 2, 0, scr, r, lane);
        }
        { const size_t n4 = (size_t)DEPTH * M * PLE / 4; const size_t gt = (size_t)vcu * 512 + tid, NT_ = (size_t)G * 512;
          for (size_t i = gt; i < n4; i += NT_) { const f32x4 v = *(const f32x4*)(pin + 4 * i); u32x2 w; w.x = cvtpk(v[0], v[1]); w.y = cvtpk(v[2], v[3]); *(u32x2*)(PB + 4 * i) = w; } }
        { const int gt = vcu * 512 + tid, NT_ = G * 512;
          for (int i = gt; i < M * 32; i += NT_) { const int m = i >> 5, fi = i & 31; const float ang = __fmul_rn((float)positions[m], a.invf[fi]);
              const double rev = (double)ang * 0.15915494309189533577; const float fr = (float)(rev - rint(rev));
              rope[2 * i] = __builtin_amdgcn_cosf(fr); rope[2 * i + 1] = __builtin_amdgcn_sinf(fr); } }
        row_pass<0>(x, U, nullptr, 0.f, nullptr, RS, nullptr, gw, NGW, lane);
    }
    grid.sync();

    for (int L_ = 0; L_ < DEPTH; ++L_) {
        int L = L_; asm volatile("" : "+s"(L));
        const bf16_t* wl = (const bf16_t*)(ws + WS_W + (size_t)L * LAYER_W);
        const size_t go = (size_t)L * DM;
        if (PH & 2) { pg8::Gemm g{U, wl + O_WGU1 / 2, M, 2 * DFF, DM}; pg8::StaticOrder S; S.init(M, 2 * DFF, G, bx); pg8::EpiSwiglu E{ACT, RS};
          pg8::gemm_phase<pg8::EpiSwiglu, pg8::StaticOrder, true, true>(lds, g, S, E); }
        GRID_SYNC();
        if (PH & 4) { pg8::Gemm g{ACT, wl + O_WD1 / 2, M, DM, DFF}; pg8::StaticOrder S; S.init(M, DM, G, bx); pg8::EpiPlain E{F, DM};
          pg8::gemm_phase<pg8::EpiPlain, pg8::StaticOrder, true, true>(lds, g, S, E); }
        GRID_SYNC();
        row_pass<1>(nullptr, U, F, 0.5f, (const float*)a.in[6] + go, RS, nullptr, gw, NGW, lane);
        GRID_SYNC();
        if (PH & 16) { pg8::Gemm g{U, wl + O_WIN / 2, M, DIN, DM}; pg8::StaticOrder S; S.init(M, DIN, G, bx); pg8::EpiWin E{R, rope, RS};
          pg8::gemm_phase<pg8::EpiWin, pg8::StaticOrder, true, true>(lds, g, S, E); }
        GRID_SYNC();
        {
            const float* lp = (const float*)a.in[9] + (size_t)L * 256;
            const float s1 = wave_sum(lp[lane] * lp[64 + lane]), s2 = wave_sum(lp[128 + lane] * lp[192 + lane]);
            const float lam_init = a.lam_init[L], lam = expf(s1) - expf(s2) + lam_init;
            const float* subg = (const float*)a.in[10] + (size_t)L * 128;
            const bf16_t* SBQ = R + (R_SBQ / 2); const bf16_t* SBK = R + (R_SBK / 2); const bf16_t* SBV = R + (R_SBV / 2);
            const bf16_t* DFQ = R + (R_DFQ / 2); const bf16_t* DFK = R + (R_DFK / 2); const bf16_t* DFV = R + (R_DFV / 2);
            for (int rep_ = 0; rep_ < ATT_REP; ++rep_) {
            if (PH & 32) for (int un = vcu; un < 256; un += G) { const int bh = un >> 4, sidx = un & 15;
                att::df_unit(lds, bh >> 2, bh & 3, 31 - sidx, DFQ, DFK, DFV, ODF, lam, 1.0f - lam_init, subg);
                att::df_unit(lds, bh >> 2, bh & 3, sidx, DFQ, DFK, DFV, ODF, lam, 1.0f - lam_init, subg); }
            if (PH & 64) for (int un = vcu; un < 512; un += G) { const int bh = un >> 4, qb = un & 15;
                att::sb_unit(lds, bh >> 3, bh & 7, qb, SBQ, SBK, SBV, OSB); }
            }
        }
        GRID_SYNC();
        if (PH & 128) { pg8::Gemm g{OSB, wl + O_WBS / 2, M, DM, 512}; pg8::StaticOrder S; S.init(M, DM, G, bx); pg8::EpiTwo<0> E{TMP, GSB, nullptr, nullptr};
          pg8::gemm_phase<pg8::EpiTwo<0>, pg8::StaticOrder, true, true>(lds, g, S, E); }
        if (PH & 128) { pg8::Gemm g{ODF, wl + O_WBD / 2, M, DM, 512}; pg8::StaticOrder S; S.init(M, DM, G, bx); pg8::EpiTwo<1> E{TMP, GDF, MRG, nullptr};
          pg8::gemm_phase<pg8::EpiTwo<1>, pg8::StaticOrder, true, true>(lds, g, S, E); }
        GRID_SYNC();
        if (PH & 4) { pg8::Gemm g{MRG, wl + O_WOUT / 2, M, DM, DM}; pg8::StaticOrder S; S.init(M, DM, G, bx); pg8::EpiPlain E{F, DM};
          pg8::gemm_phase<pg8::EpiPlain, pg8::StaticOrder, true, true>(lds, g, S, E); }
        GRID_SYNC();
        row_pass<1>(nullptr, U, F, 1.0f, (const float*)a.in[14] + go, RS, nullptr, gw, NGW, lane);
        GRID_SYNC();
        if (PH & 2) { pg8::Gemm g{U, wl + O_WGU2 / 2, M, 2 * DFF, DM}; pg8::StaticOrder S; S.init(M, 2 * DFF, G, bx); pg8::EpiSwiglu E{ACT, RS};
          pg8::gemm_phase<pg8::EpiSwiglu, pg8::StaticOrder, true, true>(lds, g, S, E); }
        GRID_SYNC();
        if (PH & 4) { pg8::Gemm g{ACT, wl + O_WD2 / 2, M, DM, DFF}; pg8::StaticOrder S; S.init(M, DM, G, bx); pg8::EpiPlain E{F, DM};
          pg8::gemm_phase<pg8::EpiPlain, pg8::StaticOrder, true, true>(lds, g, S, E); }
        GRID_SYNC();
        row_pass<1>(nullptr, U, F, 0.5f, (const float*)a.in[18] + go, RS, nullptr, gw, NGW, lane);
        GRID_SYNC();
        if (PH & 256) { pg8::Gemm g{U, wl + O_WPG / 2, M, DM, DM}; pg8::StaticOrder S; S.init(M, DM, G, bx); pg8::EpiTwo<2> E{TMP, nullptr, nullptr, RS};
          pg8::gemm_phase<pg8::EpiTwo<2>, pg8::StaticOrder, true, true>(lds, g, S, E); }
        if (PH & 256) { pg8::Gemm g{PB + (size_t)L * M * PLE, wl + O_WPP / 2, M, DM, PLE}; pg8::StaticOrder S; S.init(M, DM, G, bx); pg8::EpiTwo<3> E{TMP, nullptr, F, nullptr};
          pg8::gemm_phase<pg8::EpiTwo<3>, pg8::StaticOrder, true, true>(lds, g, S, E); }
        GRID_SYNC();
        if (L + 1 < DEPTH) row_pass<1>(nullptr, U, F, 1.0f, (const float*)a.in[22] + go, RS, nullptr, gw, NGW, lane);
        else row_pass<2>(nullptr, U, F, 1.0f, (const float*)a.in[22] + go, nullptr, a.out, gw, NGW, lane);
        if (L + 1 < DEPTH) GRID_SYNC();
    }
}

extern "C" void kernel_launch(void* const* d_in, const int* in_sizes, int n_in, void* d_out, int out_size, void* d_ws, size_t ws_size, hipStream_t stream) {
    static int grid_blocks = 0;
    if (grid_blocks == 0) {
        if (n_in != 23 || out_size != M * DM || ws_size < WS_END) { fprintf(stderr, "kernel_launch: unexpected shapes (n_in %d out %d ws %zu)\n", n_in, out_size, ws_size); grid_blocks = -1; return; }
        int dev = 0, cus = 0, per_cu = 0;
        hipGetDevice(&dev);
        hipDeviceGetAttribute(&cus, hipDeviceAttributeMultiprocessorCount, dev);
        if (hipFuncSetAttribute((const void*)fwd_megakernel, hipFuncAttributeMaxDynamicSharedMemorySize, LDS_BYTES) != hipSuccess) { fprintf(stderr, "kernel_launch: hipFuncSetAttribute failed\n"); grid_blocks = -1; return; }
        if (hipOccupancyMaxActiveBlocksPerMultiprocessor(&per_cu, (const void*)fwd_megakernel, 512, LDS_BYTES) != hipSuccess || per_cu < 1) { fprintf(stderr, "kernel_launch: occupancy query failed (%d)\n", per_cu); per_cu = 1; }
        (void)hipGetLastError();
        grid_blocks = cus * per_cu;
    }
    if (grid_blocks < 0) return;
    Args a{};
    for (int i = 0; i < 23; ++i) a.in[i] = d_in[i];
    a.out = (float*)d_out; a.ws = (unsigned char*)d_ws;
    for (int i = 0; i < 32; ++i) a.invf[i] = powf(10000.0f, -(float)i / 32.0f);
    for (int i = 0; i < 4; ++i) a.lam_init[i] = (float)(0.8 - 0.6 * exp(-0.3 * (double)i));
    if (hipMemsetAsync((unsigned char*)d_ws + WS_CTL, 0, CTL_BYTES, stream) != hipSuccess) { fprintf(stderr, "kernel_launch: memset failed\n"); return; }
    void* args[] = {&a};
    hipError_t e = hipLaunchCooperativeKernel((const void*)fwd_megakernel, dim3(grid_blocks), dim3(512), args, LDS_BYTES, stream);
    if (e != hipSuccess) fprintf(stderr, "cooperative launch failed: %s (grid %d)\n", hipGetErrorString(e), grid_blocks);
}
```

```cpp
#include <hip/hip_runtime.h>
#include <hip/hip_cooperative_groups.h>
#include <cstdio>
#include <cstdint>
#include <cmath>
namespace cg = cooperative_groups;
namespace pg8 {
#define PG8_LAS __attribute__((address_space(3)))
typedef unsigned short bf16_t;
typedef short bf16x8 __attribute__((ext_vector_type(8)));
typedef float f32x4 __attribute__((ext_vector_type(4)));
typedef unsigned u32x4 __attribute__((ext_vector_type(4)));
constexpr int BM = 256, BK = 64, HALF = 128, HTB = HALF * BK * 2  , STAGE_BYTES = 8 * HTB, NXCD = 8, WGM = 8;

__host__ __device__ __forceinline__ int lds_byte(int r, int c) { const int st = (r >> 4) * 2 + (c >> 5), rr = r & 15, cc = c & 31, ob = rr * 64 + cc * 2; return st * 1024 + (ob ^ (((ob >> 9) & 1) << 5)); }
__host__ __device__ __forceinline__ void stage_rc(int b, int& R, int& C) { const int st = b / 1024, sb = b % 1024, swz = sb ^ (((sb >> 9) & 1) << 5); R = (st >> 1) * 16 + swz / 64; C = (st & 1) * 32 + (swz % 64) / 2; }
__host__ __device__ __forceinline__ int perm32(int rho) { const int n = rho >> 4, i = rho & 15; return 8 * (i >> 2) + 4 * n + (i & 3); }

struct Unit { int pm, pn; };
struct Gemm { const bf16_t* A; const bf16_t* Bt; int M, N, K; };

struct StaticOrder {
    int nM, nN, nwg, G, c;
    __host__ __device__ void init(int M, int N, int G_, int c_) { nM = M / BM; nN = N / BM; nwg = nM * nN; G = G_; c = c_; }
    __host__ __device__ bool next(int i, Unit& u) const {
        const long L = (long)i * G + c; if (L >= nwg) return false;
        int wgid = (int)L; { const int q = nwg / NXCD, r = nwg % NXCD, xcd = wgid % NXCD, off = wgid / NXCD; wgid = (xcd < r ? xcd * (q + 1) : r * (q + 1) + (xcd - r) * q) + off; }
        const int nig = WGM * nN, gid = wgid / nig, fm = gid * WGM, gsz = (nM - fm) < WGM ? (nM - fm) : WGM;
        u.pm = fm + ((wgid % nig) % gsz); u.pn = (wgid % nig) / gsz; return true;
    }
    __device__ __forceinline__ void a_ready(const Unit&) const {}
    __device__ __forceinline__ void done(const Unit&) const {}
};

}
namespace pg8 {
template <class Epi, class Sched, bool ALIGN_EPI = false, bool SP2 = false>
__device__ __forceinline__ void gemm_phase(PG8_LAS unsigned char* lds, const Gemm g, const Sched& S, const Epi& E) {
    int tid_ = threadIdx.x; asm volatile("" : "+v"(tid_));
    const int tid = tid_, wid = __builtin_amdgcn_readfirstlane(tid >> 6), lane = tid & 63, wr = wid >> 2, wc = wid & 3, fr = lane & 15, fq = lane >> 4;
    const int K = g.K, nt = K / BK;
    unsigned voffA[2], voffB[2];
#pragma unroll
    for (int i = 0; i < 2; ++i) { int R, C; stage_rc(tid * 16 + i * 8192, R, C); const int Rb = Epi::PERM ? ((R & ~31) + perm32(R & 31)) : R;
        voffA[i] = (unsigned)(R * K + C) * 2u; voffB[i] = (unsigned)(Rb * K + C) * 2u; }
    const size_t kstep = (size_t)(BK * 2);
    const size_t hstep = (size_t)HALF * K * 2;
    const size_t tstep = 2 * hstep;
    const unsigned ldsw = (unsigned)wid * 1024u;
    const int aoff = lds_byte(wr * 64 + fr, fq * 8), boff = lds_byte(wc * 32 + fr, fq * 8);
#define PG8_SA(b, h) (((b) * 2 + (h)) * HTB)
#define PG8_SB(b, h) ((4 + (b) * 2 + (h)) * HTB)
#define PG8_STAGE(bufoff, gbase, voff) do { _Pragma("unroll") for (int _i = 0; _i < 2; ++_i) \
        __builtin_amdgcn_global_load_lds((const unsigned*)((const char*)(gbase) + (voff)[_i]), (PG8_LAS unsigned*)(lds + (bufoff) + ldsw + _i * 8192), 16, 0, 0); } while (0)
#define PG8_LDA(dst, b, h) do { _Pragma("unroll") for (int m = 0; m < 4; ++m) _Pragma("unroll") for (int k = 0; k < 2; ++k) dst[m][k] = *(const PG8_LAS bf16x8*)(lds + PG8_SA(b, h) + aoff + m * 2048 + k * 1024); } while (0)
#define PG8_LDB(dst, b, h) do { _Pragma("unroll") for (int n = 0; n < 2; ++n) _Pragma("unroll") for (int k = 0; k < 2; ++k) dst[n][k] = *(const PG8_LAS bf16x8*)(lds + PG8_SB(b, h) + boff + n * 2048 + k * 1024); } while (0)
#define PG8_MMA(ai, bj, At, Bt) do { __builtin_amdgcn_s_setprio(1); _Pragma("unroll") for (int m = 0; m < 4; ++m) _Pragma("unroll") for (int n = 0; n < 2; ++n) _Pragma("unroll") for (int k = 0; k < 2; ++k) \
        acc[ai][bj][m][n] = __builtin_amdgcn_mfma_f32_16x16x32_bf16(Bt[n][k], At[m][k], acc[ai][bj][m][n], 0, 0, 0); __builtin_amdgcn_s_setprio(0); } while (0)
#define PG8_WAIT_V(n) asm volatile("s_waitcnt vmcnt(" #n ")" ::: "memory")
#define PG8_WAIT_L(n) asm volatile("s_waitcnt lgkmcnt(" #n ")" ::: "memory")
#define PG8_BAR __builtin_amdgcn_s_barrier()
#define PG8_SCHED __builtin_amdgcn_sched_barrier(0)
    Unit cur, nxt; int ui = 0;
    if (!S.next(0, cur)) return;
    f32x4 acc[2][2][4][2];
#pragma unroll
    for (int a = 0; a < 2; ++a)
#pragma unroll
        for (int b = 0; b < 2; ++b)
#pragma unroll
            for (int m = 0; m < 4; ++m)
#pragma unroll
                for (int n = 0; n < 2; ++n) acc[a][b][m][n] = (f32x4){0.f, 0.f, 0.f, 0.f};
    bf16x8 At[4][2], B0[2][2], B1[2][2];
    const char* cA = (const char*)g.A + (size_t)cur.pm * tstep; const char* cB = (const char*)g.Bt + (size_t)cur.pn * tstep;
    S.a_ready(cur);
    if constexpr (SP2) {
        PG8_STAGE(PG8_SB(0, 0), cB, voffB); PG8_STAGE(PG8_SB(0, 1), cB + hstep, voffB); PG8_STAGE(PG8_SA(0, 0), cA, voffA); PG8_STAGE(PG8_SA(0, 1), cA + hstep, voffA);
        if (wr == 1) PG8_BAR;
        PG8_WAIT_V(2); PG8_BAR;
        PG8_STAGE(PG8_SB(1, 0), cB + kstep, voffB); PG8_STAGE(PG8_SA(1, 0), cA + kstep, voffA); PG8_STAGE(PG8_SB(1, 1), cB + hstep + kstep, voffB);
        PG8_WAIT_V(6); PG8_BAR;
    } else {
        PG8_STAGE(PG8_SB(0, 0), cB, voffB); PG8_STAGE(PG8_SA(0, 0), cA, voffA); PG8_STAGE(PG8_SB(0, 1), cB + hstep, voffB); PG8_STAGE(PG8_SA(0, 1), cA + hstep, voffA);
        if (wr == 1) PG8_BAR;
        PG8_WAIT_V(4); PG8_BAR;
        PG8_STAGE(PG8_SB(1, 0), cB + kstep, voffB); PG8_STAGE(PG8_SA(1, 0), cA + kstep, voffA); PG8_STAGE(PG8_SB(1, 1), cB + hstep + kstep, voffB);
        PG8_WAIT_V(6); PG8_BAR;
    }
    for (;;) {
        const bool has_next = S.next(ui + 1, nxt);
        const char* nA = has_next ? (const char*)g.A + (size_t)nxt.pm * tstep : cA; const char* nB = has_next ? (const char*)g.Bt + (size_t)nxt.pn * tstep : cB;
#pragma unroll 1
        for (int t = 0; t < nt; t += 2) {
            const bool last = (t == nt - 2);
            const char* a1 = cA + (size_t)(t + 1) * kstep;
            const char* a2 = last ? nA : cA + (size_t)(t + 2) * kstep; const char* b2 = last ? nB : cB + (size_t)(t + 2) * kstep;
            const char* a3 = a2 + kstep; const char* b3 = b2 + kstep;
            if (last && has_next) S.a_ready(nxt);
            if constexpr (SP2) {
            PG8_LDB(B0, 0, 0); PG8_LDB(B1, 0, 1); PG8_SCHED; PG8_LDA(At, 0, 0); PG8_STAGE(PG8_SA(1, 1), a1 + hstep, voffA);
            PG8_WAIT_V(8); PG8_WAIT_L(0); PG8_BAR; PG8_MMA(0, 0, At, B0); PG8_MMA(0, 1, At, B1); PG8_BAR; PG8_SCHED;
            PG8_LDA(At, 0, 1); PG8_STAGE(PG8_SB(0, 0), b2, voffB); PG8_STAGE(PG8_SB(0, 1), b2 + hstep, voffB); PG8_STAGE(PG8_SA(0, 0), a2, voffA);
            PG8_WAIT_V(8); PG8_WAIT_L(0); PG8_BAR; PG8_MMA(1, 0, At, B0); PG8_MMA(1, 1, At, B1); PG8_BAR; PG8_SCHED;
            PG8_LDB(B0, 1, 0); PG8_LDB(B1, 1, 1); PG8_SCHED; PG8_LDA(At, 1, 0); PG8_STAGE(PG8_SA(0, 1), a2 + hstep, voffA);
            PG8_WAIT_V(8); PG8_WAIT_L(0); PG8_BAR; PG8_MMA(0, 0, At, B0); PG8_MMA(0, 1, At, B1); PG8_BAR; PG8_SCHED;
            PG8_LDA(At, 1, 1); PG8_STAGE(PG8_SB(1, 0), b3, voffB); PG8_STAGE(PG8_SB(1, 1), b3 + hstep, voffB); PG8_STAGE(PG8_SA(1, 0), a3, voffA);
            PG8_WAIT_V(8); PG8_WAIT_L(0); PG8_BAR; PG8_MMA(1, 0, At, B0); PG8_MMA(1, 1, At, B1); PG8_BAR; PG8_SCHED;
            } else {
            PG8_LDB(B0, 0, 0); PG8_SCHED; PG8_LDA(At, 0, 0); PG8_STAGE(PG8_SA(1, 1), a1 + hstep, voffA);
            PG8_WAIT_L(8); PG8_BAR; PG8_WAIT_L(0); PG8_MMA(0, 0, At, B0); PG8_BAR; PG8_SCHED;
            PG8_LDB(B1, 0, 1); PG8_STAGE(PG8_SB(0, 0), b2, voffB);
            PG8_BAR; PG8_WAIT_L(0); PG8_MMA(0, 1, At, B1); PG8_BAR;
            PG8_LDA(At, 0, 1); PG8_STAGE(PG8_SA(0, 0), a2, voffA);
            PG8_BAR; PG8_WAIT_L(0); PG8_MMA(1, 0, At, B0); PG8_BAR; PG8_SCHED;
            PG8_STAGE(PG8_SB(0, 1), b2 + hstep, voffB);
            PG8_WAIT_V(6); PG8_BAR; PG8_MMA(1, 1, At, B1); PG8_BAR;
            PG8_LDB(B0, 1, 0); PG8_SCHED; PG8_LDA(At, 1, 0); PG8_STAGE(PG8_SA(0, 1), a2 + hstep, voffA);
            PG8_WAIT_L(8); PG8_BAR; PG8_WAIT_L(0); PG8_MMA(0, 0, At, B0); PG8_BAR; PG8_SCHED;
            PG8_LDB(B1, 1, 1); PG8_STAGE(PG8_SB(1, 0), b3, voffB);
            PG8_BAR; PG8_WAIT_L(0); PG8_MMA(0, 1, At, B1); PG8_BAR;
            PG8_LDA(At, 1, 1); PG8_STAGE(PG8_SA(1, 0), a3, voffA);
            PG8_BAR; PG8_WAIT_L(0); PG8_MMA(1, 0, At, B0); PG8_BAR; PG8_SCHED;
            PG8_STAGE(PG8_SB(1, 1), b3 + hstep, voffB);
            PG8_WAIT_V(6); PG8_BAR; PG8_MMA(1, 1, At, B1); PG8_BAR;
            }
        }
        if constexpr (ALIGN_EPI) { if (wr == 0) PG8_BAR; }
        if constexpr (!Epi::AFTER_DRAIN) { E(acc, cur, wr, wc, fr, fq); S.done(cur); }
        if (!has_next) break;
#pragma unroll
        for (int a = 0; a < 2; ++a)
#pragma unroll
            for (int b = 0; b < 2; ++b)
#pragma unroll
                for (int m = 0; m < 4; ++m)
#pragma unroll
                    for (int n = 0; n < 2; ++n) acc[a][b][m][n] = (f32x4){0.f, 0.f, 0.f, 0.f};
        cur = nxt; cA = nA; cB = nB; ++ui;
        if constexpr (ALIGN_EPI) { if (wr == 1) PG8_BAR; }
    }
    PG8_WAIT_V(0);
    if constexpr (!ALIGN_EPI) { if (wr == 0) PG8_BAR; }
    PG8_BAR;
    if constexpr (Epi::AFTER_DRAIN) { E.fused(acc, cur, wr, wc, fr, fq, lds, wid, lane); S.done(cur); }
#undef PG8_SA
#undef PG8_SB
#undef PG8_STAGE
#undef PG8_LDA
#undef PG8_LDB
#undef PG8_MMA
#undef PG8_WAIT_V
#undef PG8_WAIT_L
#undef PG8_BAR
#undef PG8_SCHED
}
}
#define LAS __attribute__((address_space(3)))
typedef unsigned short bf16_t;
typedef short bf16x8 __attribute__((ext_vector_type(8)));
typedef short s16x4 __attribute__((ext_vector_type(4)));
typedef float f32x4 __attribute__((ext_vector_type(4)));
typedef float f32x16 __attribute__((ext_vector_type(16)));
typedef unsigned u32x4 __attribute__((ext_vector_type(4)));
typedef unsigned u32x2 __attribute__((ext_vector_type(2)));

constexpr int NB = 4, SEQ = 4096, DM = 1024, DFF = 2816, DIN = 5120, DEPTH = 4, PLE = 256;
constexpr int M = NB * SEQ;
constexpr size_t MiB = 1u << 20;
constexpr size_t SZ_WGU = (size_t)2 * DFF * DM * 2, SZ_WD = (size_t)DM * DFF * 2, SZ_WIN = (size_t)DIN * DM * 2, SZ_WB = (size_t)DM * 512 * 2, SZ_WO = (size_t)DM * DM * 2, SZ_WPP = (size_t)DM * PLE * 2;
constexpr size_t O_WGU1 = 0, O_WD1 = O_WGU1 + SZ_WGU, O_WIN = O_WD1 + SZ_WD, O_WBS = O_WIN + SZ_WIN, O_WBD = O_WBS + SZ_WB, O_WOUT = O_WBD + SZ_WB, O_WGU2 = O_WOUT + SZ_WO,
                 O_WD2 = O_WGU2 + SZ_WGU, O_WPG = O_WD2 + SZ_WD, O_WPP = O_WPG + SZ_WO, LAYER_W = O_WPP + SZ_WPP;
constexpr size_t WS_CTL = 198 * MiB, CTL_BYTES = 16384; constexpr int XCD_BAR_WORDS_C = 3456;
constexpr size_t WS_W = 0, WS_U = 200 * MiB, WS_F = 232 * MiB, WS_P = 264 * MiB, WS_ROPE = 296 * MiB, WS_R = 300 * MiB, WS_END = 492 * MiB;
static_assert(LAYER_W * DEPTH <= WS_CTL && XCD_BAR_WORDS_C * 4 <= CTL_BYTES, "weights fit");
constexpr int LDS_MISC = 131072;
constexpr size_t R_SBQ = 0, R_SBK = 16 * MiB, R_SBV = 32 * MiB, R_DFQ = 48 * MiB, R_DFK = 64 * MiB, R_DFV = 80 * MiB, R_GSB = 96 * MiB, R_GDF = 128 * MiB, R_OSB = 160 * MiB, R_ODF = 176 * MiB;
constexpr size_t R_TMP = 0, R_MRG = 64 * MiB, R_ACT = 0;
constexpr int LDS_BYTES = 147456;
#ifndef PH
#define PH 0xffff
#endif
#ifndef SYNC_REP
#define SYNC_REP 1
#endif
#ifndef ATT_REP
#define ATT_REP 1
#endif
#ifndef ROW_REP
#define ROW_REP 1
#endif
#define GRID_SYNC() do { for (int r_ = 0; r_ < SYNC_REP; ++r_) xcd_barrier(bar); } while (0)

struct Args {
    const void* in[23];
    float* out;
    unsigned char* ws;
    float invf[32];
    float lam_init[4];
};
static_assert(sizeof(Args) % 8 == 0, "no tail padding");

typedef float f32x2_t __attribute__((ext_vector_type(2))); typedef __bf16 bf16x2_t __attribute__((ext_vector_type(2)));
__device__ __forceinline__ unsigned cvtpk(float lo, float hi) { f32x2_t v = {lo, hi}; bf16x2_t b = __builtin_convertvector(v, bf16x2_t); return __builtin_bit_cast(unsigned, b); }
__device__ __forceinline__ float bflo(unsigned w) { return __uint_as_float(w << 16); }
__device__ __forceinline__ float bfhi(unsigned w) { return __uint_as_float(w & 0xffff0000u); }
__device__ __forceinline__ float wave_sum(float v) {
#pragma unroll
    for (int o = 1; o < 64; o <<= 1) v += __shfl_xor(v, o);
    return v;
}
__device__ __forceinline__ float sigmoidf_(float x) { return __builtin_amdgcn_rcpf(1.0f + __expf(-x)); }

namespace pg8 {
typedef f32x4 (acc_t)[2][2][4][2];
__device__ __forceinline__ u32x4 pack8(const f32x4 v0, const f32x4 v1) { u32x4 w; w.x = cvtpk(v0[0], v0[1]); w.y = cvtpk(v0[2], v0[3]); w.z = cvtpk(v1[0], v1[1]); w.w = cvtpk(v1[2], v1[3]); return w; }
__device__ __forceinline__ void unpack8(const u32x4 w, f32x4& v0, f32x4& v1) { v0 = (f32x4){bflo(w.x), bfhi(w.x), bflo(w.y), bfhi(w.y)}; v1 = (f32x4){bflo(w.z), bfhi(w.z), bflo(w.w), bfhi(w.w)}; }

struct EpiPlain {
    static constexpr bool PERM = true, AFTER_DRAIN = false;
    bf16_t* O; int ldc;
    __device__ __forceinline__ void operator()(const f32x4 (&acc)[2][2][4][2], const Unit& u, int wr, int wc, int fr, int fq) const {
        const int row0 = u.pm * BM + wr * 64 + fr, col0 = u.pn * BM + wc * 32 + 8 * fq;
#pragma unroll
        for (int ai = 0; ai < 2; ++ai)
#pragma unroll
            for (int m = 0; m < 4; ++m) { bf16_t* rowp = O + (size_t)(row0 + ai * HALF + m * 16) * ldc + col0;
#pragma unroll
                for (int bj = 0; bj < 2; ++bj) *(u32x4*)(rowp + bj * HALF) = pack8(acc[ai][bj][m][0], acc[ai][bj][m][1]); }
    }
};
struct EpiSwiglu {
    static constexpr bool PERM = true, AFTER_DRAIN = false;
    bf16_t* O; const float* rs;
    __device__ __forceinline__ void operator()(const f32x4 (&acc)[2][2][4][2], const Unit& u, int wr, int wc, int fr, int fq) const {
        const int row0 = u.pm * BM + wr * 64 + fr, col0 = u.pn * HALF + wc * 32 + 8 * fq;
#pragma unroll
        for (int ai = 0; ai < 2; ++ai)
#pragma unroll
            for (int m = 0; m < 4; ++m) { bf16_t* rowp = O + (size_t)(row0 + ai * HALF + m * 16) * DFF + col0; const float rv = rs[row0 + ai * HALF + m * 16];
                f32x4 o[2];
#pragma unroll
                for (int n = 0; n < 2; ++n) { const f32x4 g = acc[ai][0][m][n] * rv, uu = acc[ai][1][m][n] * rv;
#pragma unroll
                    for (int e = 0; e < 4; ++e) o[n][e] = g[e] * sigmoidf_(g[e]) * uu[e]; }
                *(u32x4*)rowp = pack8(o[0], o[1]); }
    }
};
struct EpiWin {
    static constexpr bool PERM = true, AFTER_DRAIN = false;
    bf16_t* R; const float* rope; const float* rs;
    __device__ __forceinline__ void operator()(const f32x4 (&acc)[2][2][4][2], const Unit& u, int wr, int wc, int fr, int fq) const {
        const int pn = u.pn, row0 = u.pm * BM + wr * 64 + fr, cl = wc * 32 + 8 * fq;
        if (pn < 12) {
            const int sec = pn >> 1;
            bf16_t* base = R + (size_t)sec * ((size_t)M * 512) + (pn & 1) * 256 + cl;
            const float sc = (sec == 0 || sec == 3) ? 0.125f * 1.4426950408889634f : 1.0f;
            const bool rp = (sec == 3) || (sec == 4);
#pragma unroll
            for (int ai = 0; ai < 2; ++ai)
#pragma unroll
                for (int m = 0; m < 4; ++m) { const int row = row0 + ai * HALF + m * 16; const float scr_ = sc * rs[row];
                    f32x4 cs0 = {1.f, 0.f, 1.f, 0.f}, cs1 = {1.f, 0.f, 1.f, 0.f};
                    if (rp) { const float* rt = rope + (size_t)row * 64 + (16 * (wc & 1) + 4 * fq) * 2; cs0 = *(const f32x4*)rt; cs1 = *(const f32x4*)(rt + 4); }
                    const f32x4 cc = {cs0[0], cs0[2], cs1[0], cs1[2]}, ss = {cs0[1], cs0[3], cs1[1], cs1[3]};
#pragma unroll
                    for (int bj = 0; bj < 2; ++bj) { const f32x4 x1 = acc[ai][bj][m][0] * scr_, x2 = acc[ai][bj][m][1] * scr_;
                        const f32x4 y1 = x1 * cc - x2 * ss, y2 = x2 * cc + x1 * ss;
                        *(u32x4*)(base + (size_t)row * 512 + bj * HALF) = pack8(y1, y2); } }
        } else {
            const int t = pn - 12;
            bf16_t* base = R + (size_t)6 * ((size_t)M * 512) + (size_t)(t >> 2) * ((size_t)M * 1024) + (t & 3) * 256 + cl;
#pragma unroll
            for (int ai = 0; ai < 2; ++ai)
#pragma unroll
                for (int m = 0; m < 4; ++m) { const int row = row0 + ai * HALF + m * 16; const float rv = rs[row];
#pragma unroll
                    for (int bj = 0; bj < 2; ++bj) { f32x4 v0 = acc[ai][bj][m][0] * rv, v1 = acc[ai][bj][m][1] * rv;
#pragma unroll
                        for (int e = 0; e < 4; ++e) { v0[e] = sigmoidf_(v0[e]); v1[e] = sigmoidf_(v1[e]); }
                        *(u32x4*)(base + (size_t)row * 1024 + bj * HALF) = pack8(v0, v1); } }
        }
    }
};
template <int MODE> struct EpiTwo {
    static constexpr bool PERM = true, AFTER_DRAIN = false;
    bf16_t* tmp; const bf16_t* G; bf16_t* O; const float* rs;
    __device__ __forceinline__ void operator()(const f32x4 (&acc)[2][2][4][2], const Unit& u, int wr, int wc, int fr, int fq) const {
        const int row0 = u.pm * BM + wr * 64 + fr, col0 = u.pn * BM + wc * 32 + 8 * fq;
#pragma unroll
        for (int ai = 0; ai < 2; ++ai)
#pragma unroll
            for (int m = 0; m < 4; ++m) { const size_t off = (size_t)(row0 + ai * HALF + m * 16) * 1024 + col0; const float rv = (MODE == 2) ? rs[row0 + ai * HALF + m * 16] : 1.0f;
#pragma unroll
                for (int bj = 0; bj < 2; ++bj) { f32x4 v0 = acc[ai][bj][m][0] * rv, v1 = acc[ai][bj][m][1] * rv; const size_t o2 = off + bj * HALF;
                    if (MODE == 0 || MODE == 1) { f32x4 g0, g1; unpack8(*(const u32x4*)(G + o2), g0, g1); v0 = v0 * g0; v1 = v1 * g1; }
                    if (MODE == 2) {
#pragma unroll
                        for (int e = 0; e < 4; ++e) { v0[e] = sigmoidf_(v0[e]); v1[e] = sigmoidf_(v1[e]); } }
                    if (MODE == 0 || MODE == 2) { *(u32x4*)(tmp + o2) = pack8(v0, v1); }
                    else { f32x4 t0, t1; unpack8(*(const u32x4*)(tmp + o2), t0, t1);
                        if (MODE == 1) { v0 = v0 + t0; v1 = v1 + t1; } else { v0 = v0 * t0; v1 = v1 * t1; }
                        *(u32x4*)(O + o2) = pack8(v0, v1); } } }
    }
};
}

namespace att {
#define MFMA32(a, b, c) __builtin_amdgcn_mfma_f32_32x32x16_bf16((a), (b), (c), 0, 0, 0)
typedef short v4i16_t __attribute__((ext_vector_type(4)));
__device__ __forceinline__ int crow(int r, int hi) { return (r & 3) + 8 * (r >> 2) + 4 * hi; }
__device__ __forceinline__ void halves(float v, float& lo, float& hi) { auto rr = __builtin_amdgcn_permlane32_swap(__float_as_uint(v), __float_as_uint(v), false, false); lo = __uint_as_float(rr[0]); hi = __uint_as_float(rr[1]); }
__device__ __forceinline__ s16x4 vtr(LAS const unsigned char* p) { return __builtin_bit_cast(s16x4, __builtin_amdgcn_ds_read_tr16_b64_v4i16((LAS v4i16_t*)p)); }
__device__ __forceinline__ bf16x8 cat8(s16x4 a, s16x4 b) { return (bf16x8){a[0], a[1], a[2], a[3], b[0], b[1], b[2], b[3]}; }
__device__ __forceinline__ bf16x8 packp(const f32x16& p, int s) { u32x4 w; w.x = cvtpk(p[8 * s], p[8 * s + 1]); w.y = cvtpk(p[8 * s + 2], p[8 * s + 3]); w.z = cvtpk(p[8 * s + 4], p[8 * s + 5]); w.w = cvtpk(p[8 * s + 6], p[8 * s + 7]); return __builtin_bit_cast(bf16x8, w); }

#define SCHED_FENCE() __builtin_amdgcn_sched_barrier(0)
__device__ __forceinline__ void qk_tile(LAS const unsigned char* kb, const bf16x8 (&qr)[4], f32x16& p0, f32x16& p1) {
    bf16x8 kf[8];
#pragma unroll
    for (int d0 = 0; d0 < 4; ++d0) { kf[2 * d0] = *(LAS const bf16x8*)(kb + d0 * 2048); kf[2 * d0 + 1] = *(LAS const bf16x8*)(kb + d0 * 2048 + 512); }
    SCHED_FENCE();
    p0 = MFMA32(kf[0], qr[0], (f32x16){}); p1 = MFMA32(kf[1], qr[0], (f32x16){});
#pragma unroll
    for (int d0 = 1; d0 < 4; ++d0) { p0 = MFMA32(kf[2 * d0], qr[d0], p0); p1 = MFMA32(kf[2 * d0 + 1], qr[d0], p1); }
}
__device__ __forceinline__ void vread8(s16x4 (&dst)[8], LAS const unsigned char* vb, int d) {
#pragma unroll
    for (int ks = 0; ks < 4; ++ks) { dst[2 * ks] = vtr(vb + (d * 4 + ks) * 1024); dst[2 * ks + 1] = vtr(vb + (d * 4 + ks) * 1024 + 512); }
}
__device__ __forceinline__ void pv4(f32x16& o, const bf16x8 (&pa)[4], const s16x4 (&vf)[8]) {
#pragma unroll
    for (int ks = 0; ks < 4; ++ks) o = MFMA32(pa[ks], cat8(vf[2 * ks], vf[2 * ks + 1]), o);
}
__device__ __forceinline__ void df_unit(LAS unsigned char* lds, int b, int h, int qb, const bf16_t* __restrict__ Q, const bf16_t* __restrict__ K, const bf16_t* __restrict__ V, bf16_t* __restrict__ O,
                                        float lam, float oscale, const float* __restrict__ subg) {
    int tid_ = threadIdx.x; asm volatile("" : "+v"(tid_));
    const int tid = tid_, lane = tid & 63, wid = __builtin_amdgcn_readfirstlane(tid >> 6), r32 = lane & 31, hi = lane >> 5;
    const int c = wid >> 2, wq = wid & 3;
    const size_t rowbase = (size_t)b * SEQ;
    const int q0 = qb * 128, qw0 = q0 + 32 * wq, NT = (q0 + 128) / 64;
    const bf16_t* kg = K + (rowbase + lane) * 512 + h * 128 + wid * 8;
    const bf16_t* vg = V + (rowbase + 16 * (wid & 3) + (lane >> 2)) * 512 + h * 128 + (wid >> 2) * 32 + (lane & 3) * 8;
    u32x4 rk1, rk2, rv0, rv1;
#define DF_LOAD(t) do { const size_t off_ = (size_t)(t) * 64 * 512; rk1 = *(const u32x4*)(kg + off_); rk2 = *(const u32x4*)(kg + off_ + 64); rv0 = *(const u32x4*)(vg + off_); rv1 = *(const u32x4*)(vg + off_ + 64); } while (0)
#define DF_STORE(s) do { LAS unsigned char* sb_ = lds + (s) * 32768 + wid * 1024 + lane * 16; *(LAS u32x4*)(sb_) = rk1; *(LAS u32x4*)(sb_ + 8192) = rk2; *(LAS u32x4*)(sb_ + 16384) = rv0; *(LAS u32x4*)(sb_ + 24576) = rv1; } while (0)
    bf16x8 qr[4];
    { const bf16_t* qp = Q + (rowbase + qw0 + r32) * 512 + h * 128 + c * 64 + hi * 8;
#pragma unroll
      for (int d0 = 0; d0 < 4; ++d0) { qr[d0] = *(const bf16x8*)(qp + d0 * 16); asm volatile("" : "+v"(qr[d0])); } }
    float m_run = -1e30f, l_run = 0.f;
    f32x16 o[4];
#pragma unroll
    for (int d = 0; d < 4; ++d) o[d] = (f32x16){};
    DF_LOAD(0); DF_STORE(0); __syncthreads();
    for (int kt = 0; kt < NT; ++kt) {
        const int s = kt & 1;
        if (kt + 1 < NT) DF_LOAD(kt + 1);
        if (64 * kt <= qw0 + 31) {
            LAS const unsigned char* kb = lds + s * 32768 + c * 8192 + hi * 1024 + r32 * 16;
            LAS const unsigned char* vb = lds + s * 32768 + 16384 + ((lane >> 4) & 1) * 32 + (lane & 3) * 8 + (4 * hi + ((lane & 15) >> 2)) * 64;
            f32x16 p0, p1;
            qk_tile(kb, qr, p0, p1);
            s16x4 va[8], vc[8];
            vread8(va, vb, 0);
            SCHED_FENCE();
            if (64 * kt + 63 > qw0) { const int q = qw0 + r32, kb0 = 64 * kt + 4 * hi;
#pragma unroll
                for (int r = 0; r < 16; ++r) { const int key = kb0 + (r & 3) + 8 * (r >> 2); if (key > q) p0[r] = -INFINITY; if (key + 32 > q) p1[r] = -INFINITY; } }
            float mx = fmaxf(p0[0], p1[0]);
#pragma unroll
            for (int r = 1; r < 16; ++r) mx = fmaxf(mx, fmaxf(p0[r], p1[r]));
            { float a_, b_; halves(mx, a_, b_); mx = fmaxf(a_, b_); }
            const bool grow = mx > m_run + 8.0f;
            const float mn = grow ? mx : m_run, sc = __builtin_amdgcn_exp2f(m_run - mn);
            m_run = mn;
            float rs = 0.f;
#pragma unroll
            for (int r = 0; r < 16; ++r) { p0[r] = __builtin_amdgcn_exp2f(p0[r] - mn); p1[r] = __builtin_amdgcn_exp2f(p1[r] - mn); rs += p0[r] + p1[r]; }
            l_run = l_run * sc + rs;
            if (__any(grow)) {
#pragma unroll
                for (int r = 0; r < 16; ++r) { const float f = __shfl(sc, crow(r, hi));
#pragma unroll
                    for (int d = 0; d < 4; ++d) o[d][r] *= f; }
            }
            bf16x8 pa[4]; pa[0] = packp(p0, 0); pa[1] = packp(p0, 1); pa[2] = packp(p1, 0); pa[3] = packp(p1, 1);
            SCHED_FENCE();
            vread8(vc, vb, 1); SCHED_FENCE(); pv4(o[0], pa, va); SCHED_FENCE();
            vread8(va, vb, 2); SCHED_FENCE(); pv4(o[1], pa, vc); SCHED_FENCE();
            vread8(vc, vb, 3); SCHED_FENCE(); pv4(o[2], pa, va); SCHED_FENCE();
            pv4(o[3], pa, vc);
        }
        if (kt + 1 < NT) DF_STORE(s ^ 1);
        __syncthreads();
    }
#undef DF_LOAD
#undef DF_STORE
    LAS float* ob = (LAS float*)lds;
    float l_lo, l_hi; halves(l_run, l_lo, l_hi);
    const float linv_own = 1.0f / (l_lo + l_hi);
    const float wgt = (c == 1) ? -lam : 1.0f;
    if (c == 1) {
#pragma unroll
        for (int r = 0; r < 16; ++r) { const float f = __shfl(linv_own, crow(r, hi)) * wgt; const int row = 32 * wq + crow(r, hi);
#pragma unroll
            for (int d = 0; d < 4; ++d) ob[row * 132 + 32 * d + r32] = o[d][r] * f; }
    }
    __syncthreads();
    if (c == 0) {
#pragma unroll
        for (int r = 0; r < 16; ++r) { const float f = __shfl(linv_own, crow(r, hi)); const int row = 32 * wq + crow(r, hi);
#pragma unroll
            for (int d = 0; d < 4; ++d) ob[row * 132 + 32 * d + r32] += o[d][r] * f; }
    }
    __syncthreads();
    { const int row = tid >> 2, part = tid & 3; const LAS float* rp = ob + row * 132 + part * 32;
      f32x4 v[8]; float ss = 0.f;
#pragma unroll
      for (int j = 0; j < 8; ++j) { v[j] = *(const LAS f32x4*)(rp + 4 * j); ss += (v[j][0] * v[j][0] + v[j][1] * v[j][1]) + (v[j][2] * v[j][2] + v[j][3] * v[j][3]); }
      ss += __shfl_xor(ss, 1); ss += __shfl_xor(ss, 2);
      const float rn = oscale / sqrtf(ss * (1.0f / 128.0f) + 1e-5f);
      bf16_t* op = O + (rowbase + q0 + row) * 512 + h * 128 + part * 32;
#pragma unroll
      for (int j = 0; j < 4; ++j) { const f32x4 g0 = *(const f32x4*)(subg + part * 32 + 8 * j), g1 = *(const f32x4*)(subg + part * 32 + 8 * j + 4);
          const f32x4 a = v[2 * j] * g0 * rn, bb = v[2 * j + 1] * g1 * rn;
          u32x4 w; w.x = cvtpk(a[0], a[1]); w.y = cvtpk(a[2], a[3]); w.z = cvtpk(bb[0], bb[1]); w.w = cvtpk(bb[2], bb[3]);
          *(u32x4*)(op + 8 * j) = w; } }
    __syncthreads();
}

__device__ __forceinline__ void sb_unit(LAS unsigned char* lds, int b, int h, int qb, const bf16_t* __restrict__ Q, const bf16_t* __restrict__ K, const bf16_t* __restrict__ V, bf16_t* __restrict__ O) {
    int tid_ = threadIdx.x; asm volatile("" : "+v"(tid_));
    const int tid = tid_, lane = tid & 63, wid = __builtin_amdgcn_readfirstlane(tid >> 6), r32 = lane & 31, hi = lane >> 5;
    const size_t rowbase = (size_t)b * SEQ;
    const int q0 = qb * 256, qw0 = q0 + 32 * wid, kt_hi = (q0 + 256) / 64 - 1;
    const bf16_t* kg = K + (rowbase + lane) * 512 + h * 64 + wid * 8;
    const bf16_t* vg = V + (rowbase + 16 * (wid & 3) + (lane >> 2)) * 512 + h * 64 + (wid >> 2) * 32 + (lane & 3) * 8;
    LAS unsigned* flags = (LAS unsigned*)(lds + 32768);
    LAS unsigned char* ost = lds + 36864 + wid * 4608;
    u32x4 rk, rv;
#define SB_LOAD(t) do { const size_t off_ = (size_t)(t) * 64 * 512; rk = *(const u32x4*)(kg + off_); rv = *(const u32x4*)(vg + off_); } while (0)
#define SB_STORE(s) do { LAS unsigned char* sb_ = lds + (s) * 16384 + wid * 1024 + lane * 16; *(LAS u32x4*)(sb_) = rk; *(LAS u32x4*)(sb_ + 8192) = rv; } while (0)
    bf16x8 qr[4];
    { const bf16_t* qp = Q + (rowbase + qw0 + r32) * 512 + h * 64 + hi * 8;
#pragma unroll
      for (int d0 = 0; d0 < 4; ++d0) { qr[d0] = *(const bf16x8*)(qp + d0 * 16); asm volatile("" : "+v"(qr[d0])); } }
    float carry = 0.f; bool done = false;
    f32x16 o[2]; o[0] = (f32x16){}; o[1] = (f32x16){};
    SB_LOAD(kt_hi); SB_STORE(0); __syncthreads();
    int it = 0;
    for (int kt = kt_hi; kt >= 0; --kt, ++it) {
        const int s = it & 1;
        if (kt > 0) SB_LOAD(kt - 1);
        if (!done && 64 * kt < qw0 + 31) {
            LAS const unsigned char* kb = lds + s * 16384 + hi * 1024 + r32 * 16;
            LAS const unsigned char* vb = lds + s * 16384 + 8192 + ((lane >> 4) & 1) * 32 + (lane & 3) * 8 + (4 * hi + ((lane & 15) >> 2)) * 64;
            f32x16 p0, p1;
            qk_tile(kb, qr, p0, p1);
            s16x4 va[8], vc[8];
            vread8(va, vb, 0); vread8(vc, vb, 1);
            SCHED_FENCE();
            const int q = qw0 + r32, kb0 = 64 * kt + 4 * hi;
            f32x16 L0, L1;
#pragma unroll
            for (int r = 0; r < 16; ++r) {
                { const float z = p0[r], sp = __builtin_amdgcn_logf(1.0f + __builtin_amdgcn_exp2f(fminf(z, 100.f))); L0[r] = -sp; p0[r] = z - sp; }
                { const float z = p1[r], sp = __builtin_amdgcn_logf(1.0f + __builtin_amdgcn_exp2f(fminf(z, 100.f))); L1[r] = -sp; p1[r] = z - sp; } }
            if (64 * kt + 63 >= qw0) {
#pragma unroll
                for (int r = 0; r < 16; ++r) { const int key = kb0 + (r & 3) + 8 * (r >> 2);
                    if (!(key < q)) { L0[r] = 0.f; p0[r] = -1e30f; }
                    if (!(key + 32 < q)) { L1[r] = 0.f; p1[r] = -1e30f; } } }
            float own[8], par[8], S[8];
#pragma unroll
            for (int j = 0; j < 4; ++j) { own[j] = (L0[4 * j] + L0[4 * j + 1]) + (L0[4 * j + 2] + L0[4 * j + 3]); own[4 + j] = (L1[4 * j] + L1[4 * j + 1]) + (L1[4 * j + 2] + L1[4 * j + 3]); }
#pragma unroll
            for (int j = 0; j < 8; ++j) { float a_, b_; halves(own[j], a_, b_); par[j] = (__float_as_uint(a_) == __float_as_uint(own[j])) ? b_ : a_; }
            S[7] = 0.f;
#pragma unroll
            for (int j = 6; j >= 0; --j) S[j] = S[j + 1] + (own[j + 1] + par[j + 1]);
            const float total = S[0] + (own[0] + par[0]);
#pragma unroll
            for (int j = 0; j < 8; ++j) { const float lg = carry + S[j] + (hi == 0 ? par[j] : 0.f);
                if (j < 4) { const int rb = 4 * j; const float l3 = lg, l2 = l3 + L0[rb + 3], l1 = l2 + L0[rb + 2], l0 = l1 + L0[rb + 1];
                    p0[rb] = __builtin_amdgcn_exp2f(p0[rb] + l0); p0[rb + 1] = __builtin_amdgcn_exp2f(p0[rb + 1] + l1); p0[rb + 2] = __builtin_amdgcn_exp2f(p0[rb + 2] + l2); p0[rb + 3] = __builtin_amdgcn_exp2f(p0[rb + 3] + l3); }
                else { const int rb = 4 * (j - 4); const float l3 = lg, l2 = l3 + L1[rb + 3], l1 = l2 + L1[rb + 2], l0 = l1 + L1[rb + 1];
                    p1[rb] = __builtin_amdgcn_exp2f(p1[rb] + l0); p1[rb + 1] = __builtin_amdgcn_exp2f(p1[rb + 1] + l1); p1[rb + 2] = __builtin_amdgcn_exp2f(p1[rb + 2] + l2); p1[rb + 3] = __builtin_amdgcn_exp2f(p1[rb + 3] + l3); } }
            carry += total;
            bf16x8 pa[4]; pa[0] = packp(p0, 0); pa[1] = packp(p0, 1); pa[2] = packp(p1, 0); pa[3] = packp(p1, 1);
            SCHED_FENCE();
            pv4(o[0], pa, va); pv4(o[1], pa, vc);
            done = __all(carry < -151.0f) != 0;
        }
        if (lane == 0) flags[s * 8 + wid] = done ? 1u : 0u;
        if (kt > 0) SB_STORE(s ^ 1);
        __syncthreads();
        unsigned all = 1u;
#pragma unroll
        for (int w = 0; w < 8; ++w) all &= flags[s * 8 + w];
        if (all) break;
    }
#undef SB_LOAD
#undef SB_STORE
#pragma unroll
    for (int d = 0; d < 2; ++d)
#pragma unroll
        for (int r = 0; r < 16; r += 2) { const unsigned w = cvtpk(o[d][r], o[d][r + 1]);
            *(LAS unsigned short*)(ost + crow(r, hi) * 144 + (32 * d + r32) * 2) = (unsigned short)(w & 0xffffu);
            *(LAS unsigned short*)(ost + crow(r + 1, hi) * 144 + (32 * d + r32) * 2) = (unsigned short)(w >> 16); }
    asm volatile("s_waitcnt lgkmcnt(0)" ::: "memory");
#pragma unroll
    for (int j = 0; j < 4; ++j) { const int idx = lane + 64 * j, row = idx >> 3, ch = idx & 7;
        const u32x4 w = *(LAS const u32x4*)(ost + row * 144 + ch * 16);
        *(u32x4*)(O + (rowbase + qw0 + row) * 512 + h * 64 + ch * 8) = w; }
    __syncthreads();
}
}

__device__ __forceinline__ int dest_row(int mode, int c) {
    if (mode == 1) { return (c < DFF) ? (256 * (c >> 7) + (c & 127)) : (256 * ((c - DFF) >> 7) + 128 + ((c - DFF) & 127)); }
    if (mode == 2) { if (c >= 1536 && c < 2560) { const int j = c & 63, half = j >> 5, q = (j & 31) >> 2, e = j & 3; return (c & ~63) + 8 * q + 4 * half + e; } return c; }
    return c;
}
__device__ __forceinline__ void transpose_item(const float* __restrict__ W, int K, int N, bf16_t* __restrict__ WT, int mode, LAS float* scr, int item, int lane, const float* __restrict__ gk = nullptr) {
    const int nblk = N / 32, kb = item / nblk, nb = item % nblk, k0 = 64 * kb, n0 = 32 * nb;
#pragma unroll 8
    for (int i = 0; i < 32; ++i) { const int kk = 2 * i + (lane >> 5); const float gg = gk ? gk[k0 + kk] : 1.0f; scr[kk * 33 + (lane & 31)] = W[(size_t)(k0 + kk) * N + n0 + (lane & 31)] * gg; }
    asm volatile("s_waitcnt lgkmcnt(0)" ::: "memory");
    const int c = lane & 7;
#pragma unroll
    for (int j = 0; j < 4; ++j) { const int n = (lane >> 3) + 8 * j; const LAS float* s = scr + (8 * c) * 33 + n;
        u32x4 o; o.x = cvtpk(s[0 * 33], s[1 * 33]); o.y = cvtpk(s[2 * 33], s[3 * 33]); o.z = cvtpk(s[4 * 33], s[5 * 33]); o.w = cvtpk(s[6 * 33], s[7 * 33]);
        *(u32x4*)(WT + (size_t)dest_row(mode, n0 + n) * K + k0 + 8 * c) = o; }
    asm volatile("s_waitcnt lgkmcnt(0)" ::: "memory");
}

template <int MODE>
__device__ __forceinline__ void row_pass(const float* __restrict__ xin, bf16_t* __restrict__ H, const bf16_t* __restrict__ F, float coef, const float* __restrict__ gpost, float* __restrict__ rs,
                                         float* __restrict__ fout, int gw, int NGW, int lane_in) {
    int lane = lane_in; asm volatile("" : "+v"(lane));
    constexpr int RB = 4;
    f32x4 gp[4];
#pragma unroll
    for (int j = 0; j < 4; ++j) gp[j] = (MODE != 0) ? *(const f32x4*)(gpost + 256 * j + 4 * lane) : (f32x4){0.f, 0.f, 0.f, 0.f};
    for (int ck = gw; ck < M / RB; ck += NGW) {
        const int m0 = ck * RB;
        f32x4 hv[RB][4]; float red[RB];
        if (MODE == 0) {
#pragma unroll
            for (int i = 0; i < RB; ++i)
#pragma unroll
                for (int j = 0; j < 4; ++j) hv[i][j] = *(const f32x4*)(xin + (size_t)(m0 + i) * DM + 256 * j + 4 * lane);
        } else {
            u32x2 fw[RB][4], hw[RB][4];
#pragma unroll
            for (int i = 0; i < RB; ++i)
#pragma unroll
                for (int j = 0; j < 4; ++j) { fw[i][j] = *(const u32x2*)(F + (size_t)(m0 + i) * DM + 256 * j + 4 * lane); hw[i][j] = *(const u32x2*)(H + (size_t)(m0 + i) * DM + 256 * j + 4 * lane); }
            f32x4 fv[RB][4];
#pragma unroll
            for (int i = 0; i < RB; ++i) { float ss = 0.f;
#pragma unroll
                for (int j = 0; j < 4; ++j) { fv[i][j] = (f32x4){bflo(fw[i][j].x), bfhi(fw[i][j].x), bflo(fw[i][j].y), bfhi(fw[i][j].y)}; hv[i][j] = (f32x4){bflo(hw[i][j].x), bfhi(hw[i][j].x), bflo(hw[i][j].y), bfhi(hw[i][j].y)};
                    ss += (fv[i][j][0] * fv[i][j][0] + fv[i][j][1] * fv[i][j][1]) + (fv[i][j][2] * fv[i][j][2] + fv[i][j][3] * fv[i][j][3]); }
                red[i] = ss; }
#pragma unroll
            for (int o = 1; o < 64; o <<= 1)
#pragma unroll
                for (int i = 0; i < RB; ++i) red[i] += __shfl_xor(red[i], o);
#pragma unroll
            for (int i = 0; i < RB; ++i) { const float r = coef / sqrtf(red[i] * (1.0f / DM) + 1e-6f);
#pragma unroll
                for (int j = 0; j < 4; ++j) hv[i][j] = hv[i][j] + fv[i][j] * gp[j] * r; }
        }
        if (MODE == 2) {
#pragma unroll
            for (int i = 0; i < RB; ++i)
#pragma unroll
                for (int j = 0; j < 4; ++j) *(f32x4*)(fout + (size_t)(m0 + i) * DM + 256 * j + 4 * lane) = hv[i][j];
        } else {
#pragma unroll
            for (int i = 0; i < RB; ++i) { float s2 = 0.f;
#pragma unroll
                for (int j = 0; j < 4; ++j) { s2 += (hv[i][j][0] * hv[i][j][0] + hv[i][j][1] * hv[i][j][1]) + (hv[i][j][2] * hv[i][j][2] + hv[i][j][3] * hv[i][j][3]);
                    u32x2 w; w.x = cvtpk(hv[i][j][0], hv[i][j][1]); w.y = cvtpk(hv[i][j][2], hv[i][j][3]); *(u32x2*)(H + (size_t)(m0 + i) * DM + 256 * j + 4 * lane) = w; }
                red[i] = s2; }
#pragma unroll
            for (int o = 1; o < 64; o <<= 1)
#pragma unroll
                for (int i = 0; i < RB; ++i) red[i] += __shfl_xor(red[i], o);
            if (lane < RB) { float v = red[0];
#pragma unroll
                for (int i = 1; i < RB; ++i) v = (lane == i) ? red[i] : v;
                rs[m0 + lane] = 1.0f / sqrtf(v * (1.0f / DM) + 1e-6f); }
        }
    }
}

#define XB_TMO      128
#define XB_XCNT(j)  (256  + 64 * (j))
#define XB_XSUB(j)  (1280 + 64 * (j))
#define XB_XGEN(j)  (2304 + 64 * (j))
#define XB_TOP      3328
#define XB_TOPGEN   3392
#define XCD_BAR_WORDS 3456
#define XB_SPIN_CAP (1u << 18)

__device__ __forceinline__ unsigned xb_ld(unsigned* p)              { return __hip_atomic_load(p, __ATOMIC_RELAXED, __HIP_MEMORY_SCOPE_AGENT); }
__device__ __forceinline__ unsigned xb_add(unsigned* p, unsigned v) { return __hip_atomic_fetch_add(p, v, __ATOMIC_RELAXED, __HIP_MEMORY_SCOPE_AGENT); }
__device__ __forceinline__ unsigned xb_xcc_id() { return (unsigned)__builtin_amdgcn_s_getreg((3 << 11) | 20) & 0xFu; }
#define XB_SPIN(cond, bar) do { unsigned _sp = 0; while (cond) { __builtin_amdgcn_s_sleep(1); \
    if ((++_sp & 255u) == 0u) { if (xb_ld(&(bar)[XB_TMO])) break; if (_sp > XB_SPIN_CAP) { atomicAdd(&(bar)[XB_TMO], 1u); break; } } } } while (0)

struct XcdBarrier {
    unsigned* bar; unsigned x;
    volatile LAS unsigned* st;
};

__device__ __forceinline__ XcdBarrier xcd_barrier_post(unsigned* bar, volatile LAS unsigned* st) {
    XcdBarrier b; b.bar = bar; b.x = xb_xcc_id(); b.st = st;
    if (threadIdx.x == 0) (void)xb_add(&bar[XB_XCNT(b.x)], 1u);
    return b;
}
__device__ __forceinline__ void xcd_barrier_complete(unsigned* bar, unsigned x, unsigned& nloc, unsigned& nx) {
    const unsigned G = gridDim.x * gridDim.y * gridDim.z;
    unsigned sum, cnt, mine, sp = 0u;
    for (;;) {
        sum = 0u; cnt = 0u; mine = 0u;
#pragma unroll
        for (unsigned j = 0; j < 16; ++j) { const unsigned c = xb_ld(&bar[XB_XCNT(j)]); sum += c; cnt += (c > 0u) ? 1u : 0u; mine = (j == x) ? c : mine; }
        if (sum == G) break;
        __builtin_amdgcn_s_sleep(1);
        if ((++sp & 255u) == 0u) { if (xb_ld(&bar[XB_TMO])) break; if (sp > XB_SPIN_CAP) { atomicAdd(&bar[XB_TMO], 1u); break; } }
    }
    nloc = mine > 0u ? mine : 1u; nx = cnt > 0u ? cnt : 1u;
}

__device__ __forceinline__ void xcd_barrier(const XcdBarrier& b) {
    asm volatile("s_waitcnt vmcnt(0)" ::: "memory");
    __syncthreads();
    if (threadIdx.x == 0) {
        unsigned* bar = b.bar;
        __builtin_amdgcn_s_waitcnt(0);
        unsigned nloc = b.st[0], nx = b.st[1];
        if (nloc == 0u) { xcd_barrier_complete(bar, b.x, nloc, nx); b.st[0] = nloc; b.st[1] = nx; }
        const unsigned old = xb_add(&bar[XB_XSUB(b.x)], 1u);
        const unsigned gen = old / nloc;
        if (old + 1u == (gen + 1u) * nloc) {
            __builtin_amdgcn_fence(__ATOMIC_RELEASE, "agent");
            asm volatile("s_waitcnt vmcnt(0)" ::: "memory");
            const unsigned og = xb_add(&bar[XB_TOP], 1u);
            const unsigned tg = og / nx;
            if (og + 1u == (tg + 1u) * nx) xb_add(&bar[XB_TOPGEN], 1u);
            else XB_SPIN(xb_ld(&bar[XB_TOPGEN]) == tg, bar);
            __builtin_amdgcn_fence(__ATOMIC_ACQUIRE, "agent");
            xb_add(&bar[XB_XGEN(b.x)], 1u);
            asm volatile("s_waitcnt vmcnt(0)" ::: "memory");
        } else {
            XB_SPIN(xb_ld(&bar[XB_XGEN(b.x)]) == gen, bar);
            __builtin_amdgcn_fence(__ATOMIC_ACQUIRE, "agent");
            asm volatile("s_waitcnt vmcnt(0)" ::: "memory");
        }
    }
    __syncthreads();
}


__global__ void __launch_bounds__(512, 2) fwd_megakernel(Args a) {
    extern __shared__ __attribute__((aligned(16))) unsigned char lds_raw[];
    LAS unsigned char* lds = (LAS unsigned char*)lds_raw;
    cg::grid_group grid = cg::this_grid();
    const int tid = threadIdx.x, lane = tid & 63, wave = __builtin_amdgcn_readfirstlane(tid >> 6);
    const int G = gridDim.x, bx = blockIdx.x, vcu = (G % 8 == 0) ? (bx % 8) * (G / 8) + bx / 8 : bx;
    const int gw = vcu * 8 + wave, NGW = G * 8;
    unsigned char* ws = a.ws;
    if (tid < 16) ((LAS unsigned*)(lds + LDS_MISC))[tid] = 0u;
    __syncthreads();
    XcdBarrier bar = xcd_barrier_post((unsigned*)(ws + WS_CTL), (volatile LAS unsigned*)(lds + LDS_MISC));
    const float* x = (const float*)a.in[0];
    const float* pin = (const float*)a.in[1];
    const int* positions = (const int*)a.in[2];
    bf16_t* U = (bf16_t*)(ws + WS_U);
    float* RS = (float*)(ws + WS_CTL + 65536);
    bf16_t* F = (bf16_t*)(ws + WS_F);
    bf16_t* PB = (bf16_t*)(ws + WS_P);
    float* rope = (float*)(ws + WS_ROPE);
    bf16_t* R = (bf16_t*)(ws + WS_R);
    bf16_t* ACT = (bf16_t*)(ws + WS_R + R_ACT);
    bf16_t* TMP = (bf16_t*)(ws + WS_R + R_TMP);
    bf16_t* MRG = (bf16_t*)(ws + WS_R + R_MRG);
    bf16_t* GSB = (bf16_t*)(ws + WS_R + R_GSB);
    bf16_t* GDF = (bf16_t*)(ws + WS_R + R_GDF);
    bf16_t* OSB = (bf16_t*)(ws + WS_R + R_OSB);
    bf16_t* ODF = (bf16_t*)(ws + WS_R + R_ODF);

    if (PH & 1) {
        LAS float* scr = (LAS float*)(lds + wave * 16384);
        constexpr int I_GU = (DM / 64) * (2 * DFF / 32), I_D = (DFF / 64) * (DM / 32), I_IN = (DM / 64) * (DIN / 32), I_B = (512 / 64) * (DM / 32), I_O = (DM / 64) * (DM / 32), I_PP = (PLE / 64) * (DM / 32);
        constexpr int I_LAYER = 2 * I_GU + 2 * I_D + I_IN + 2 * I_B + 2 * I_O + I_PP;
        for (int it = gw; it < DEPTH * I_LAYER; it += NGW) {
            const int L = it / I_LAYER; int r = it % I_LAYER;
            bf16_t* wl = (bf16_t*)(ws + WS_W + (size_t)L * LAYER_W);
            if (r < I_GU) { transpose_item((const float*)a.in[4] + (size_t)L * DM * 2 * DFF, DM, 2 * DFF, wl + O_WGU1 / 2, 1, scr, r, lane, (const float*)a.in[3] + (size_t)L * DM); continue; } r -= I_GU;
            if (r < I_D) { transpose_item((const float*)a.in[5] + (size_t)L * DFF * DM, DFF, DM, wl + O_WD1 / 2, 0, scr, r, lane); continue; } r -= I_D;
            if (r < I_IN) { transpose_item((const float*)a.in[8] + (size_t)L * DM * DIN, DM, DIN, wl + O_WIN / 2, 2, scr, r, lane, (const float*)a.in[7] + (size_t)L * DM); continue; } r -= I_IN;
            if (r < I_B) { transpose_item((const float*)a.in[11] + (size_t)L * 512 * DM, 512, DM, wl + O_WBS / 2, 0, scr, r, lane); continue; } r -= I_B;
            if (r < I_B) { transpose_item((const float*)a.in[12] + (size_t)L * 512 * DM, 512, DM, wl + O_WBD / 2, 0, scr, r, lane); continue; } r -= I_B;
            if (r < I_O) { transpose_item((const float*)a.in[13] + (size_t)L * DM * DM, DM, DM, wl + O_WOUT / 2, 0, scr, r, lane); continue; } r -= I_O;
            if (r < I_GU) { transpose_item((const float*)a.in[16] + (size_t)L * DM * 2 * DFF, DM, 2 * DFF, wl + O_WGU2 / 2, 1, scr, r, lane, (const float*)a.in[15] + (size_t)L * DM); continue; } r -= I_GU;
            if (r < I_D) { transpose_item((const float*)a.in[17] + (size_t)L * DFF * DM, DFF, DM, wl + O_WD2 / 2, 0, scr, r, lane); continue; } r -= I_D;
            if (r < I_O) { transpose_item((const float*)a.in[20] + (size_t)L * DM * DM, DM, DM, wl + O_WPG / 2, 0, scr, r, lane, (const float*)a.in[19] + (size_t)L * DM); continue; } r -= I_O;
            transpose_item((const float*)a.in[21] + (size_t)L * PLE * DM, PLE, DM, wl + O_WPP / 2, 0, scr, r, lane);
        }
        { const size_t n4 = (size_t)DEPTH * M * PLE / 4; const size_t gt = (size_t)vcu * 512 + tid, NT_ = (size_t)G * 512;
          for (size_t i = gt; i < n4; i += NT_) { const f32x4 v = *(const f32x4*)(pin + 4 * i); u32x2 w; w.x = cvtpk(v[0], v[1]); w.y = cvtpk(v[2], v[3]); *(u32x2*)(PB + 4 * i) = w; } }
        { const int gt = vcu * 512 + tid, NT_ = G * 512;
          for (int i = gt; i < M * 32; i += NT_) { const int m = i >> 5, fi = i & 31; const float ang = __fmul_rn((float)positions[m], a.invf[fi]);
              const double rev = (double)ang * 0.15915494309189533577; const float fr = (float)(rev - rint(rev));
              rope[2 * i] = __builtin_amdgcn_cosf(fr); rope[2 * i + 1] = __builtin_amdgcn_sinf(fr); } }
        row_pass<0>(x, U, nullptr, 0.f, nullptr, RS, nullptr, gw, NGW, lane);
    }
    grid.sync();

    for (int L_ = 0; L_ < DEPTH; ++L_) {
        int L = L_; asm volatile("" : "+s"(L));
        const bf16_t* wl = (const bf16_t*)(ws + WS_W + (size_t)L * LAYER_W);
        const size_t go = (size_t)L * DM;
        if (PH & 2) { pg8::Gemm g{U, wl + O_WGU1 / 2, M, 2 * DFF, DM}; pg8::StaticOrder S; S.init(M, 2 * DFF, G, bx); pg8::EpiSwiglu E{ACT, RS};
          pg8::gemm_phase<pg8::EpiSwiglu, pg8::StaticOrder, true, true>(lds, g, S, E); }
        GRID_SYNC();
        if (PH & 4) { pg8::Gemm g{ACT, wl + O_WD1 / 2, M, DM, DFF}; pg8::StaticOrder S; S.init(M, DM, G, bx); pg8::EpiPlain E{F, DM};
          pg8::gemm_phase<pg8::EpiPlain, pg8::StaticOrder, true, true>(lds, g, S, E); }
        GRID_SYNC();
        row_pass<1>(nullptr, U, F, 0.5f, (const float*)a.in[6] + go, RS, nullptr, gw, NGW, lane);
        GRID_SYNC();
        if (PH & 16) { pg8::Gemm g{U, wl + O_WIN / 2, M, DIN, DM}; pg8::StaticOrder S; S.init(M, DIN, G, bx); pg8::EpiWin E{R, rope, RS};
          pg8::gemm_phase<pg8::EpiWin, pg8::StaticOrder, true, true>(lds, g, S, E); }
        GRID_SYNC();
        {
            const float* lp = (const float*)a.in[9] + (size_t)L * 256;
            const float s1 = wave_sum(lp[lane] * lp[64 + lane]), s2 = wave_sum(lp[128 + lane] * lp[192 + lane]);
            const float lam_init = a.lam_init[L], lam = expf(s1) - expf(s2) + lam_init;
            const float* subg = (const float*)a.in[10] + (size_t)L * 128;
            const bf16_t* SBQ = R + (R_SBQ / 2); const bf16_t* SBK = R + (R_SBK / 2); const bf16_t* SBV = R + (R_SBV / 2);
            const bf16_t* DFQ = R + (R_DFQ / 2); const bf16_t* DFK = R + (R_DFK / 2); const bf16_t* DFV = R + (R_DFV / 2);
            for (int rep_ = 0; rep_ < ATT_REP; ++rep_) {
            if (PH & 32) for (int un = vcu; un < 256; un += G) { const int bh = un >> 4, sidx = un & 15;
                att::df_unit(lds, bh >> 2, bh & 3, 31 - sidx, DFQ, DFK, DFV, ODF, lam, 1.0f - lam_init, subg);
                att::df_unit(lds, bh >> 2, bh & 3, sidx, DFQ, DFK, DFV, ODF, lam, 1.0f - lam_init, subg); }
            if (PH & 64) for (int un = vcu; un < 512; un += G) { const int bh = un >> 4, qb = un & 15;
                att::sb_unit(lds, bh >> 3, bh & 7, qb, SBQ, SBK, SBV, OSB); }
            }
        }
        GRID_SYNC();
        if (PH & 128) { pg8::Gemm g{OSB, wl + O_WBS / 2, M, DM, 512}; pg8::StaticOrder S; S.init(M, DM, G, bx); pg8::EpiTwo<0> E{TMP, GSB, nullptr, nullptr};
          pg8::gemm_phase<pg8::EpiTwo<0>, pg8::StaticOrder, true, true>(lds, g, S, E); }
        if (PH & 128) { pg8::Gemm g{ODF, wl + O_WBD / 2, M, DM, 512}; pg8::StaticOrder S; S.init(M, DM, G, bx); pg8::EpiTwo<1> E{TMP, GDF, MRG, nullptr};
          pg8::gemm_phase<pg8::EpiTwo<1>, pg8::StaticOrder, true, true>(lds, g, S, E); }
        GRID_SYNC();
        if (PH & 4) { pg8::Gemm g{MRG, wl + O_WOUT / 2, M, DM, DM}; pg8::StaticOrder S; S.init(M, DM, G, bx); pg8::EpiPlain E{F, DM};
          pg8::gemm_phase<pg8::EpiPlain, pg8::StaticOrder, true, true>(lds, g, S, E); }
        GRID_SYNC();
        row_pass<1>(nullptr, U, F, 1.0f, (const float*)a.in[14] + go, RS, nullptr, gw, NGW, lane);
        GRID_SYNC();
        if (PH & 2) { pg8::Gemm g{U, wl + O_WGU2 / 2, M, 2 * DFF, DM}; pg8::StaticOrder S; S.init(M, 2 * DFF, G, bx); pg8::EpiSwiglu E{ACT, RS};
          pg8::gemm_phase<pg8::EpiSwiglu, pg8::StaticOrder, true, true>(lds, g, S, E); }
        GRID_SYNC();
        if (PH & 4) { pg8::Gemm g{ACT, wl + O_WD2 / 2, M, DM, DFF}; pg8::StaticOrder S; S.init(M, DM, G, bx); pg8::EpiPlain E{F, DM};
          pg8::gemm_phase<pg8::EpiPlain, pg8::StaticOrder, true, true>(lds, g, S, E); }
        GRID_SYNC();
        row_pass<1>(nullptr, U, F, 0.5f, (const float*)a.in[18] + go, RS, nullptr, gw, NGW, lane);
        GRID_SYNC();
        if (PH & 256) { pg8::Gemm g{U, wl + O_WPG / 2, M, DM, DM}; pg8::StaticOrder S; S.init(M, DM, G, bx); pg8::EpiTwo<2> E{TMP, nullptr, nullptr, RS};
          pg8::gemm_phase<pg8::EpiTwo<2>, pg8::StaticOrder, true, true>(lds, g, S, E); }
        if (PH & 256) { pg8::Gemm g{PB + (size_t)L * M * PLE, wl + O_WPP / 2, M, DM, PLE}; pg8::StaticOrder S; S.init(M, DM, G, bx); pg8::EpiTwo<3> E{TMP, nullptr, F, nullptr};
          pg8::gemm_phase<pg8::EpiTwo<3>, pg8::StaticOrder, true, true>(lds, g, S, E); }
        GRID_SYNC();
        if (L + 1 < DEPTH) row_pass<1>(nullptr, U, F, 1.0f, (const float*)a.in[22] + go, RS, nullptr, gw, NGW, lane);
        else row_pass<2>(nullptr, U, F, 1.0f, (const float*)a.in[22] + go, nullptr, a.out, gw, NGW, lane);
        if (L + 1 < DEPTH) GRID_SYNC();
    }
}

extern "C" void kernel_launch(void* const* d_in, const int* in_sizes, int n_in, void* d_out, int out_size, void* d_ws, size_t ws_size, hipStream_t stream) {
    static int grid_blocks = 0;
    if (grid_blocks == 0) {
        if (n_in != 23 || out_size != M * DM || ws_size < WS_END) { fprintf(stderr, "kernel_launch: unexpected shapes (n_in %d out %d ws %zu)\n", n_in, out_size, ws_size); grid_blocks = -1; return; }
        int dev = 0, cus = 0, per_cu = 0;
        hipGetDevice(&dev);
        hipDeviceGetAttribute(&cus, hipDeviceAttributeMultiprocessorCount, dev);
        if (hipFuncSetAttribute((const void*)fwd_megakernel, hipFuncAttributeMaxDynamicSharedMemorySize, LDS_BYTES) != hipSuccess) { fprintf(stderr, "kernel_launch: hipFuncSetAttribute failed\n"); grid_blocks = -1; return; }
        if (hipOccupancyMaxActiveBlocksPerMultiprocessor(&per_cu, (const void*)fwd_megakernel, 512, LDS_BYTES) != hipSuccess || per_cu < 1) { fprintf(stderr, "kernel_launch: occupancy query failed (%d)\n", per_cu); per_cu = 1; }
        (void)hipGetLastError();
        grid_blocks = cus * per_cu;
    }
    if (grid_blocks < 0) return;
    Args a{};
    for (int i = 0; i < 23; ++i) a.in[i] = d_in[i];
    a.out = (float*)d_out; a.ws = (unsigned char*)d_ws;
    for (int i = 0; i < 32; ++i) a.invf[i] = powf(10000.0f, -(float)i / 32.0f);
    for (int i = 0; i < 4; ++i) a.lam_init[i] = (float)(0.8 - 0.6 * exp(-0.3 * (double)i));
    if (hipMemsetAsync((unsigned char*)d_ws + WS_CTL, 0, CTL_BYTES, stream) != hipSuccess) { fprintf(stderr, "kernel_launch: memset failed\n"); return; }
    void* args[] = {&a};
    hipError_t e = hipLaunchCooperativeKernel((const void*)fwd_megakernel, dim3(grid_blocks), dim3(512), args, LDS_BYTES, stream);
    if (e != hipSuccess) fprintf(stderr, "cooperative launch failed: %s (grid %d)\n", hipGetErrorString(e), grid_blocks);
}
```
